# Optimizing an MI355X kernel written in HIP

```python
import math
import jax, jax.numpy as jnp
from jax import lax
import numpy as np

D_MODEL = 1024
BATCH = 8
SEQ = 4096
DEPTH = 2

CHUNK = 64
Q_BLOCK = 128
ROPE_THETA = 500000.0
NORM_EPS = 1e-6

A_HEADS = 8
A_NOPE = 64
A_ROPE = 32
A_V = 64
A_Q_LORA = 256
A_KV_LORA = 128
B_HEADS = 8
B_DIM = 32
B_V = 2 * B_DIM
B_ROPE = B_DIM // 4
AB_SPLITS = [A_Q_LORA,
             A_Q_LORA + A_KV_LORA,
             A_Q_LORA + A_KV_LORA + A_ROPE,
             A_Q_LORA + A_KV_LORA + A_ROPE + B_HEADS * 2 * B_DIM,
             A_Q_LORA + A_KV_LORA + A_ROPE + 2 * B_HEADS * 2 * B_DIM]
AB_IN = A_Q_LORA + A_KV_LORA + A_ROPE + 2 * B_HEADS * 2 * B_DIM + B_HEADS * B_V
AB_OUT = A_HEADS * A_V + B_HEADS * B_V
C_HEADS = 16
C_DIM = D_MODEL // C_HEADS
C_PAST_CHUNKS = 8
C_PAST = C_PAST_CHUNKS * CHUNK
C_BAND = C_PAST + CHUNK
REL_CLIP = 128
PEER_HEADS = 8
N_KEYS = 128
N_EXPERTS = N_KEYS * N_KEYS
PEER_TOPK = 16
PEER_DQ = 256
PEER_TOKEN_BLOCK = 128

kernel_name = "hybrid_mla_diff_chunkbias_peer"


def rms_norm(x, g):
    x32 = x.astype(jnp.float32)
    y = x32 * lax.rsqrt(jnp.mean(x32 * x32, axis=-1, keepdims=True) + NORM_EPS)
    return (y * g.astype(jnp.float32)).astype(x.dtype)


def rope_tables(positions, rot_dim):
    inv_freq = ROPE_THETA ** (-jnp.arange(0, rot_dim, 2, dtype=jnp.float32) / rot_dim)
    ang = positions.astype(jnp.float32)[..., None] * inv_freq
    return jnp.cos(ang), jnp.sin(ang)


def apply_rope(x, cos, sin):
    shape = cos.shape[:2] + (1,) * (x.ndim - 3) + cos.shape[2:]
    cos = cos.reshape(shape)
    sin = sin.reshape(shape)
    x1, x2 = jnp.split(x, 2, axis=-1)
    return jnp.concatenate([x1 * cos - x2 * sin, x2 * cos + x1 * sin], axis=-1).astype(x.dtype)


def partial_rope(x, cos, sin, r):
    return jnp.concatenate([apply_rope(x[..., :r], cos, sin), x[..., r:]], axis=-1)


def to_blocks(t, blk):
    b, s = t.shape[:2]
    return jnp.moveaxis(t.reshape((b, s // blk, blk) + t.shape[2:]), 1, 0)


def from_blocks(t):
    n, b, blk = t.shape[:3]
    return jnp.moveaxis(t, 0, 1).reshape((b, n * blk) + t.shape[3:])


def chunk_causal_probs(q_blk, k, q_start, scale):
    s = jnp.einsum('bqhd,bkhd->bhqk', q_blk, k).astype(jnp.float32) * scale
    q_chunk = (q_start + jnp.arange(q_blk.shape[1])) // CHUNK
    k_chunk = jnp.arange(k.shape[1]) // CHUNK
    mask = k_chunk[None, :] <= q_chunk[:, None]
    return jax.nn.softmax(jnp.where(mask, s, -jnp.inf), axis=-1)


def blocked_softmax_attention(q, k, v, scale):
    nb = q.shape[1] // Q_BLOCK

    def body(args):
        q_blk, i = args
        p = chunk_causal_probs(q_blk, k, i * Q_BLOCK, scale)
        return jnp.einsum('bhqk,bkhd->bqhd', p.astype(v.dtype), v)

    return from_blocks(lax.map(body, (to_blocks(q, Q_BLOCK), jnp.arange(nb))))


def blocked_diff_attention(q1, k1, q2, k2, v, lam, scale):
    nb = q1.shape[1] // Q_BLOCK

    def body(args):
        q1_blk, q2_blk, i = args
        p1 = chunk_causal_probs(q1_blk, k1, i * Q_BLOCK, scale)
        p2 = chunk_causal_probs(q2_blk, k2, i * Q_BLOCK, scale)
        w = p1 - lam * p2
        return jnp.einsum('bhqk,bkhd->bqhd', w.astype(v.dtype), v)

    return from_blocks(lax.map(body, (to_blocks(q1, Q_BLOCK), to_blocks(q2, Q_BLOCK), jnp.arange(nb))))


def mixer_ab(h, w_in, q_norm_g, w_uq, kv_norm_g, w_ukv, lam_params, head_norm_g, w_out,
             rope_a, rope_b, lambda_init):
    bn, sn, _ = h.shape
    proj = h @ w_in
    q_lat, kv_lat, k_pe, bq, bk, bv = jnp.split(proj, AB_SPLITS, axis=-1)
    q = (rms_norm(q_lat, q_norm_g) @ w_uq).reshape(bn, sn, A_HEADS, A_NOPE + A_ROPE)
    q = jnp.concatenate([q[..., :A_NOPE], apply_rope(q[..., A_NOPE:], *rope_a)], axis=-1)
    kv = (rms_norm(kv_lat, kv_norm_g) @ w_ukv).reshape(bn, sn, A_HEADS, A_NOPE + A_V)
    k_pe = apply_rope(k_pe[:, :, None, :], *rope_a)
    k = jnp.concatenate([kv[..., :A_NOPE], jnp.broadcast_to(k_pe, (bn, sn, A_HEADS, A_ROPE))], axis=-1)
    a_out = blocked_softmax_attention(q, k, kv[..., A_NOPE:], (A_NOPE + A_ROPE) ** -0.5)
    bq = partial_rope(bq.reshape(bn, sn, B_HEADS, 2, B_DIM), *rope_b, B_ROPE)
    bk = partial_rope(bk.reshape(bn, sn, B_HEADS, 2, B_DIM), *rope_b, B_ROPE)
    bv = bv.reshape(bn, sn, B_HEADS, B_V)
    lp = lam_params.astype(jnp.float32)
    lam = jnp.exp(jnp.sum(lp[0] * lp[1])) - jnp.exp(jnp.sum(lp[2] * lp[3])) + lambda_init
    b_out = blocked_diff_attention(bq[..., 0, :], bk[..., 0, :], bq[..., 1, :], bk[..., 1, :],
                                   bv, lam, B_DIM ** -0.5)
    b_out = rms_norm(b_out, head_norm_g) * (1.0 - lambda_init)
    merged = jnp.concatenate([a_out.reshape(bn, sn, A_HEADS * A_V),
                              b_out.reshape(bn, sn, B_HEADS * B_V)], axis=-1)
    return merged @ w_out


def mixer_c(h, w_in, rel_bias, w_out, bias_idx):
    bn, sn, _ = h.shape
    qkv = (h @ w_in).reshape(bn, sn, 3, C_HEADS, C_DIM)
    q, k, v = qkv[:, :, 0], qkv[:, :, 1], qkv[:, :, 2]
    pad = ((0, 0), (C_PAST, 0), (0, 0), (0, 0))
    kp = jnp.pad(k, pad)
    vp = jnp.pad(v, pad)
    bias = rel_bias.astype(jnp.float32)[:, bias_idx]
    scale = C_DIM ** -0.5
    n_chunks = sn // CHUNK

    def body(args):
        q_blk, i = args
        start = i * CHUNK
        kb = lax.dynamic_slice_in_dim(kp, start, C_BAND, axis=1)
        vb = lax.dynamic_slice_in_dim(vp, start, C_BAND, axis=1)
        s = jnp.einsum('bqhd,bkhd->bhqk', q_blk, kb).astype(jnp.float32) * scale + bias
        valid = jnp.arange(C_BAND) >= C_PAST - start
        p = jax.nn.softmax(jnp.where(valid, s, -jnp.inf), axis=-1)
        return jnp.einsum('bhqk,bkhd->bqhd', p.astype(vb.dtype), vb)

    out = from_blocks(lax.map(body, (to_blocks(q, CHUNK), jnp.arange(n_chunks))))
    return out.reshape(bn, sn, D_MODEL) @ w_out


def peer_ffn(h, w_q, sub_keys, expert_u, expert_v):
    bn, sn, d = h.shape
    q = (h @ w_q).reshape(bn, sn, PEER_HEADS, 2, PEER_DQ // 2)
    scores = jnp.einsum('bshpd,hpnd->bshpn', q, sub_keys).astype(jnp.float32)
    s, i = lax.top_k(scores, PEER_TOPK)
    cand_s = (s[..., 0, :, None] + s[..., 1, None, :]).reshape(bn, sn, PEER_HEADS, PEER_TOPK * PEER_TOPK)
    cand_i = (i[..., 0, :, None] * N_KEYS + i[..., 1, None, :]).reshape(bn, sn, PEER_HEADS, PEER_TOPK * PEER_TOPK)
    top_s, pos = lax.top_k(cand_s, PEER_TOPK)
    idx = jnp.take_along_axis(cand_i, pos, axis=-1)
    gate = jax.nn.softmax(top_s, axis=-1)
    nb = (bn * sn) // PEER_TOKEN_BLOCK
    hb = h.reshape(nb, PEER_TOKEN_BLOCK, d)
    ib = idx.reshape(nb, PEER_TOKEN_BLOCK, PEER_HEADS * PEER_TOPK)
    gb = gate.reshape(nb, PEER_TOKEN_BLOCK, PEER_HEADS * PEER_TOPK)

    def body(args):
        ht, it, gt = args
        u = jnp.take(expert_u, it, axis=0)
        a = jax.nn.gelu(jnp.einsum('tkd,td->tk', u, ht).astype(jnp.float32), approximate=False) * gt
        vv = jnp.take(expert_v, it, axis=0)
        return jnp.einsum('tk,tkd->td', a.astype(vv.dtype), vv)

    return lax.map(body, (hb, ib, gb)).reshape(bn, sn, d)


def setup_inputs(seed: int = 0) -> dict:
    key = jax.random.key(seed)
    ks = jax.random.split(key, 24)
    ne = (DEPTH + 1) // 2
    no = DEPTH // 2

    def nrm(k, shape, scale):
        return jax.random.normal(k, shape, jnp.float32) * scale

    offsets = jax.random.randint(ks[2], (BATCH,), 0, 1024, dtype=jnp.int32) * CHUNK
    positions = (offsets[:, None] + jnp.arange(SEQ, dtype=jnp.int32)[None, :]).astype(jnp.int32)
    return {
        'x': nrm(ks[0], (BATCH, SEQ, D_MODEL), 1.0),
        'c': nrm(ks[1], (BATCH, D_MODEL), 1.0),
        'positions': positions,
        'ada_w': nrm(ks[3], (DEPTH, D_MODEL, 6 * D_MODEL), 0.5 * D_MODEL ** -0.5),
        'ada_b': nrm(ks[4], (DEPTH, 6 * D_MODEL), 0.01),
        'norm_mix_g': 1.0 + nrm(ks[5], (DEPTH, D_MODEL), 0.05),
        'norm_ffn_g': 1.0 + nrm(ks[6], (DEPTH, D_MODEL), 0.05),
        'w_in_ab': nrm(ks[7], (ne, D_MODEL, AB_IN), D_MODEL ** -0.5),
        'mla_q_norm_g': 1.0 + nrm(ks[8], (ne, A_Q_LORA), 0.05),
        'mla_w_uq': nrm(ks[9], (ne, A_Q_LORA, A_HEADS * (A_NOPE + A_ROPE)), A_Q_LORA ** -0.5),
        'mla_kv_norm_g': 1.0 + nrm(ks[10], (ne, A_KV_LORA), 0.05),
        'mla_w_ukv': nrm(ks[11], (ne, A_KV_LORA, A_HEADS * (A_NOPE + A_V)), A_KV_LORA ** -0.5),
        'diff_lambda': nrm(ks[12], (ne, 4, B_DIM), 0.1),
        'diff_head_norm_g': 1.0 + nrm(ks[13], (ne, B_V), 0.05),
        'w_out_ab': nrm(ks[14], (ne, AB_OUT, D_MODEL), AB_OUT ** -0.5),
        'w_in_c': nrm(ks[15], (no, D_MODEL, 3 * D_MODEL), D_MODEL ** -0.5),
        'rel_bias': nrm(ks[16], (no, C_HEADS, 2 * REL_CLIP + 1), 0.2),
        'w_out_c': nrm(ks[17], (no, D_MODEL, D_MODEL), D_MODEL ** -0.5),
        'peer_w_q': nrm(ks[18], (DEPTH, D_MODEL, PEER_HEADS * PEER_DQ), D_MODEL ** -0.5),
        'peer_sub_keys': nrm(ks[19], (DEPTH, PEER_HEADS, 2, N_KEYS, PEER_DQ // 2), (PEER_DQ // 2) ** -0.5),
        'peer_u': nrm(ks[20], (DEPTH, N_EXPERTS, D_MODEL), D_MODEL ** -0.5),
        'peer_v': nrm(ks[21], (DEPTH, N_EXPERTS, D_MODEL), PEER_HEADS ** -0.5),
        'final_norm_g': 1.0 + nrm(ks[22], (D_MODEL,), 0.05),
    }


def reference(x, c, positions, ada_w, ada_b, norm_mix_g, norm_ffn_g, w_in_ab, mla_q_norm_g,
              mla_w_uq, mla_kv_norm_g, mla_w_ukv, diff_lambda, diff_head_norm_g, w_out_ab,
              w_in_c, rel_bias, w_out_c, peer_w_q, peer_sub_keys, peer_u, peer_v, final_norm_g):
    rope_a = rope_tables(positions, A_ROPE)
    rope_b = rope_tables(positions, B_ROPE)
    rel = jnp.arange(CHUNK)[:, None] + C_PAST - jnp.arange(C_BAND)[None, :]
    bias_idx = jnp.clip(rel, -REL_CLIP, REL_CLIP) + REL_CLIP
    cond = jax.nn.silu(c)
    for l in range(DEPTH):
        mod = cond @ ada_w[l] + ada_b[l]
        sh_m, sc_m, g_m, sh_f, sc_f, g_f = jnp.split(mod[:, None, :], 6, axis=-1)
        h = rms_norm(x, norm_mix_g[l]) * (1.0 + sc_m) + sh_m
        j = l // 2
        if l % 2 == 0:
            lambda_init = 0.8 - 0.6 * math.exp(-0.3 * l)
            y = mixer_ab(h, w_in_ab[j], mla_q_norm_g[j], mla_w_uq[j], mla_kv_norm_g[j], mla_w_ukv[j],
                         diff_lambda[j], diff_head_norm_g[j], w_out_ab[j], rope_a, rope_b, lambda_init)
        else:
            y = mixer_c(h, w_in_c[j], rel_bias[j], w_out_c[j], bias_idx)
        x = x + g_m * y
        h = rms_norm(x, norm_ffn_g[l]) * (1.0 + sc_f) + sh_f
        x = x + g_f * peer_ffn(h, peer_w_q[l], peer_sub_keys[l], peer_u[l], peer_v[l])
    return rms_norm(x, final_norm_g)
```

```cpp
#include <hip/hip_runtime.h>
#include <cstdio>
#include <cstdint>
#include <cmath>

#ifndef STAGE
#define STAGE 0
#endif

#define GAS __attribute__((address_space(1)))
#define LAS __attribute__((address_space(3)))
typedef unsigned short bf16;
typedef unsigned char uchar;
typedef short bf16x8 __attribute__((ext_vector_type(8)));
typedef short s16x4 __attribute__((ext_vector_type(4)));
typedef float f32x4 __attribute__((ext_vector_type(4)));
typedef float f32x2 __attribute__((ext_vector_type(2)));
typedef float f32x16 __attribute__((ext_vector_type(16)));
typedef unsigned u32x4 __attribute__((ext_vector_type(4)));
typedef unsigned u32x2 __attribute__((ext_vector_type(2)));
typedef __bf16 bf2v __attribute__((ext_vector_type(2)));

constexpr int NB = 8, SEQ = 4096, D = 1024, T = NB * SEQ;
constexpr int AB_IN = 1952, AB_INP = 2048;
constexpr int NWAVES = 8, NTHR = 512;
constexpr float NORM_EPS = 1e-6f;
constexpr int C_QLAT = 0, C_KVLAT = 256, C_KPE = 384, C_BQ = 416, C_BK = 928, C_BV = 1440;

constexpr size_t MiB = 1u << 20;
constexpr size_t WS_CTL = 0, CTL_ZERO_BYTES = 1 * MiB;
constexpr size_t WS_MOD = 1 * MiB;
constexpr size_t WS_RSTDQ = WS_MOD + 512 * 1024;
constexpr size_t WS_RSTDKV = WS_RSTDQ + 128 * 1024;
constexpr size_t WS_ROPEA = 2 * MiB;
constexpr size_t WS_ROPEB = 6 * MiB;
constexpr size_t WS_WIN = 8 * MiB;
constexpr size_t WS_WUQ = 12 * MiB;
constexpr size_t WS_WUKV = 12 * MiB + 512 * 1024;
constexpr size_t WS_WOAB = 13 * MiB;
constexpr size_t WS_WINC = 15 * MiB;
constexpr size_t WS_WOC = 21 * MiB;
constexpr size_t WS_WCOMB = 23 * MiB;
constexpr size_t WS_EU = 32 * MiB;
constexpr size_t WS_EV = 64 * MiB;
constexpr size_t WS_H = 96 * MiB;
constexpr size_t WS_MRG = 160 * MiB;
constexpr size_t WS_R = 224 * MiB;
constexpr size_t WS_PROJ = WS_R;
constexpr size_t WS_Q = WS_R + 128 * MiB;
constexpr size_t WS_KV = WS_R + 176 * MiB;
constexpr size_t WS_QKV = WS_R;
constexpr size_t WS_SC = WS_R;
constexpr size_t WS_END = 480 * MiB;

constexpr int CW_BAR = 4096;

constexpr int RING_OFF = 0, RING_BYTES = 131072;
constexpr int LDSCTL_OFF = RING_BYTES, MISC_OFF = LDSCTL_OFF + 320;
constexpr int LDS_BYTES = 147456;

#define LDS_WAIT() asm volatile("s_waitcnt lgkmcnt(0)" ::: "memory")
#define VM_WAIT() asm volatile("s_waitcnt vmcnt(0)" ::: "memory")

__device__ __forceinline__ unsigned pk2(float lo, float hi) { f32x2 v = {lo, hi}; bf2v b = __builtin_convertvector(v, bf2v); return __builtin_bit_cast(unsigned, b); }
__device__ __forceinline__ float bf_lo(unsigned w) { return __builtin_bit_cast(float, w << 16); }
__device__ __forceinline__ float bf_hi(unsigned w) { return __builtin_bit_cast(float, w & 0xffff0000u); }

#define XB_TMO      128
#define XB_XCNT(j)  (256  + 64 * (j))
#define XB_XSUB(j)  (1280 + 64 * (j))
#define XB_XGEN(j)  (2304 + 64 * (j))
#define XB_TOP      3328
#define XB_TOPGEN   3392
#define XCD_BAR_WORDS 3456
#define XB_SPIN_CAP (1u << 18)

__device__ __forceinline__ unsigned xb_ld(unsigned* p)              { return __hip_atomic_load(p, __ATOMIC_RELAXED, __HIP_MEMORY_SCOPE_AGENT); }
__device__ __forceinline__ unsigned xb_add(unsigned* p, unsigned v) { return __hip_atomic_fetch_add(p, v, __ATOMIC_RELAXED, __HIP_MEMORY_SCOPE_AGENT); }
__device__ __forceinline__ unsigned xb_xcc_id() { return (unsigned)__builtin_amdgcn_s_getreg((3 << 11) | 20) & 0xFu; }
#define XB_SPIN(cond, bar) do { unsigned _sp = 0; while (cond) { __builtin_amdgcn_s_sleep(1); \
    if ((++_sp & 255u) == 0u) { if (xb_ld(&(bar)[XB_TMO])) break; if (_sp > XB_SPIN_CAP) { atomicAdd(&(bar)[XB_TMO], 1u); break; } } } } while (0)

struct XcdBarrier { unsigned* bar; unsigned x; volatile LAS unsigned* st; };

__device__ __forceinline__ XcdBarrier xcd_barrier_post(unsigned* bar, volatile LAS unsigned* st) {
    XcdBarrier b; b.bar = bar; b.x = xb_xcc_id(); b.st = st;
    if (threadIdx.x == 0) (void)xb_add(&bar[XB_XCNT(b.x)], 1u);
    return b;
}
__device__ __forceinline__ void xcd_barrier_complete(unsigned* bar, unsigned x, unsigned& nloc, unsigned& nx) {
    const unsigned G = gridDim.x * gridDim.y * gridDim.z;
    unsigned sum, cnt, mine, sp = 0u;
    for (;;) {
        sum = 0u; cnt = 0u; mine = 0u;
#pragma unroll
        for (unsigned j = 0; j < 16; ++j) { const unsigned c = xb_ld(&bar[XB_XCNT(j)]); sum += c; cnt += (c > 0u) ? 1u : 0u; mine = (j == x) ? c : mine; }
        if (sum == G) break;
        __builtin_amdgcn_s_sleep(1);
        if ((++sp & 255u) == 0u) { if (xb_ld(&bar[XB_TMO])) break; if (sp > XB_SPIN_CAP) { atomicAdd(&bar[XB_TMO], 1u); break; } }
    }
    nloc = mine > 0u ? mine : 1u; nx = cnt > 0u ? cnt : 1u;
}
__device__ __forceinline__ void xcd_barrier(const XcdBarrier& b, int tid_) {
    asm volatile("s_waitcnt vmcnt(0)" ::: "memory");
    __syncthreads();
    if (tid_ == 0) {
        unsigned* bar = b.bar;
        __builtin_amdgcn_s_waitcnt(0);
        unsigned nloc = b.st[0], nx = b.st[1];
        if (nloc == 0u) { xcd_barrier_complete(bar, b.x, nloc, nx); b.st[0] = nloc; b.st[1] = nx; }
        const unsigned old = xb_add(&bar[XB_XSUB(b.x)], 1u);
        const unsigned gen = old / nloc;
        if (old + 1u == (gen + 1u) * nloc) {
            __builtin_amdgcn_fence(__ATOMIC_RELEASE, "agent");
            asm volatile("s_waitcnt vmcnt(0)" ::: "memory");
            const unsigned og = xb_add(&bar[XB_TOP], 1u);
            const unsigned tg = og / nx;
            if (og + 1u == (tg + 1u) * nx) xb_add(&bar[XB_TOPGEN], 1u);
            else XB_SPIN(xb_ld(&bar[XB_TOPGEN]) == tg, bar);
            __builtin_amdgcn_fence(__ATOMIC_ACQUIRE, "agent");
            xb_add(&bar[XB_XGEN(b.x)], 1u);
            asm volatile("s_waitcnt vmcnt(0)" ::: "memory");
        } else {
            XB_SPIN(xb_ld(&bar[XB_XGEN(b.x)]) == gen, bar);
            __builtin_amdgcn_fence(__ATOMIC_ACQUIRE, "agent");
            asm volatile("s_waitcnt vmcnt(0)" ::: "memory");
        }
    }
    __syncthreads();
}

struct Args {
    const float* x; const float* c; const int* pos; const float* ada_w; const float* ada_b; const float* norm_mix_g; const float* norm_ffn_g;
    const float* w_in_ab; const float* mla_q_norm_g; const float* mla_w_uq; const float* mla_kv_norm_g; const float* mla_w_ukv; const float* diff_lambda;
    const float* diff_head_norm_g; const float* w_out_ab; const float* w_in_c; const float* rel_bias; const float* w_out_c; const float* peer_w_q;
    const float* peer_sub_keys; const float* peer_u; const float* peer_v; const float* final_norm_g;
    float* out; uchar* ws;
    float inv_freq_a[16]; float inv_freq_b[4];
};

struct Frame {
    LAS uchar* lds;
    int tid, lane, wave, vcu, G, gw, NGW;
};

__device__ __forceinline__ float shx(float v, int mask, int lane) { return __builtin_bit_cast(float, __builtin_amdgcn_ds_bpermute((lane ^ mask) << 2, __builtin_bit_cast(int, v))); }
__device__ __forceinline__ float wave_sum(float v, int lane) {
#pragma unroll
    for (int o = 1; o < 64; o <<= 1) v += shx(v, o, lane);
    return v;
}

__device__ __forceinline__ void transpose_item(const float* W, int K, int N, bf16* WT, const float* kscale, LAS float* scr, int item, int lane) {
    const int nblk = N / 32, kb = item / nblk, nb = item % nblk, k0 = 64 * kb, n0 = 32 * nb;
#pragma unroll 8
    for (int i = 0; i < 32; ++i) { const int kk = 2 * i + (lane >> 5); float v = W[(size_t)(k0 + kk) * N + n0 + (lane & 31)]; if (kscale) v *= kscale[k0 + kk]; scr[kk * 33 + (lane & 31)] = v; }
    LDS_WAIT(); asm volatile("" ::: "memory");
    const int c = lane & 7;
#pragma unroll
    for (int j = 0; j < 4; ++j) { const int n = (lane >> 3) + 8 * j; const LAS float* s = scr + (8 * c) * 33 + n;
        u32x4 o; o.x = pk2(s[0 * 33], s[1 * 33]); o.y = pk2(s[2 * 33], s[3 * 33]); o.z = pk2(s[4 * 33], s[5 * 33]); o.w = pk2(s[6 * 33], s[7 * 33]);
        *(u32x4*)(WT + (size_t)(n0 + n) * K + k0 + 8 * c) = o; }
    LDS_WAIT(); asm volatile("" ::: "memory");
}

__device__ __forceinline__ void convert_tables(const Frame& F, const Args& a, int l) {
    const size_t n8 = (size_t)16384 * 1024 / 8;
    const f32x4* su = (const f32x4*)(a.peer_u + (size_t)l * 16384 * 1024);
    const f32x4* sv = (const f32x4*)(a.peer_v + (size_t)l * 16384 * 1024);
    u32x4* du = (u32x4*)(a.ws + WS_EU); u32x4* dv = (u32x4*)(a.ws + WS_EV);
    const size_t gt = (size_t)F.vcu * NTHR + F.tid, NT = (size_t)F.G * NTHR;
    for (size_t i = gt; i < n8; i += NT) {
        const f32x4 p0 = su[2 * i], p1 = su[2 * i + 1], q0 = sv[2 * i], q1 = sv[2 * i + 1];
        u32x4 o; o.x = pk2(p0.x, p0.y); o.y = pk2(p0.z, p0.w); o.z = pk2(p1.x, p1.y); o.w = pk2(p1.z, p1.w); du[i] = o;
        u32x4 r; r.x = pk2(q0.x, q0.y); r.y = pk2(q0.z, q0.w); r.z = pk2(q1.x, q1.y); r.w = pk2(q1.z, q1.w); dv[i] = r;
    }
}

__device__ __forceinline__ float silu_f(float v) { return v / (1.f + __expf(-v)); }

__device__ __forceinline__ void p0_mod(const Frame& F, const Args& a) {
    LAS float* cond = (LAS float*)(F.lds + RING_OFF);
    LAS float* red = (LAS float*)(F.lds + RING_OFF + 32768);
    bool have = false;
    for (int it = F.vcu; it < 192; it += F.G) {
        if (!have) { for (int i = F.tid; i < 8192; i += NTHR) cond[i] = silu_f(a.c[i]); __syncthreads(); have = true; }
        const int l = it / 96, j0 = (it % 96) * 64;
        const float* W = a.ada_w + (size_t)l * 1024 * 6144 + j0 + F.lane;
        float acc[8];
#pragma unroll
        for (int b = 0; b < 8; ++b) acc[b] = 0.f;
        const int kbeg = F.wave * 128;
#pragma unroll 8
        for (int k = kbeg; k < kbeg + 128; ++k) { const float w = W[(size_t)k * 6144];
#pragma unroll
            for (int b = 0; b < 8; ++b) acc[b] += cond[b * 1024 + k] * w; }
#pragma unroll
        for (int b = 0; b < 8; ++b) red[(F.wave * 8 + b) * 64 + F.lane] = acc[b];
        __syncthreads();
        { const int b = F.tid >> 6; float s = a.ada_b[l * 6144 + j0 + F.lane];
#pragma unroll
          for (int w = 0; w < 8; ++w) s += red[(w * 8 + b) * 64 + F.lane];
          ((float*)(a.ws + WS_MOD))[(size_t)(l * 8 + b) * 6144 + j0 + F.lane] = s; }
        __syncthreads();
    }
    __syncthreads();
}

__device__ __forceinline__ void p0_rope(const Frame& F, const Args& a) {
    const int gt = F.vcu * NTHR + F.tid, NT = F.G * NTHR;
    float* ra = (float*)(a.ws + WS_ROPEA); float* rb = (float*)(a.ws + WS_ROPEB);
    for (int i = gt; i < T * 20; i += NT) {
        const int t = i / 20, f = i % 20;
        const float invf = f < 16 ? a.inv_freq_a[f] : a.inv_freq_b[f - 16];
        const float ang = (float)a.pos[t] * invf;
        const double ad = (double)ang; const double kq = rint(ad * 0.15915494309189535); const float r = (float)(ad - kq * 6.283185307179586);
        const float cs = cosf(r), sn = sinf(r);
        if (f < 16) { ra[t * 32 + f] = cs; ra[t * 32 + 16 + f] = sn; } else { rb[t * 8 + (f - 16)] = cs; rb[t * 8 + 4 + (f - 16)] = sn; }
    }
}

__device__ __forceinline__ void p0_wcomb(const Frame& F, const Args& a) {
    LAS float* skT = (LAS float*)(F.lds + RING_OFF);
    LAS float* wqT = (LAS float*)(F.lds + RING_OFF + 128 * 132 * 4);
    for (int it = F.vcu; it < 512; it += F.G) {
        const int l = it >> 8, hp = (it >> 4) & 15, kb = it & 15;
        const float* sk = a.peer_sub_keys + ((size_t)(l * 16 + hp) * 128) * 128;
        const float* wq = a.peer_w_q + (size_t)l * 1024 * 2048 + (size_t)(kb * 64) * 2048 + hp * 128;
        for (int i = F.tid; i < 128 * 128; i += NTHR) { const int n = i >> 7, d = i & 127; skT[d * 132 + n] = sk[i]; }
        for (int i = F.tid; i < 64 * 128; i += NTHR) { const int k = i >> 7, d = i & 127; wqT[d * 68 + k] = wq[(size_t)k * 2048 + d]; }
        __syncthreads();
        const int tn = F.tid & 31, tk = F.tid >> 5;
        f32x4 acc[4];
#pragma unroll
        for (int i = 0; i < 4; ++i) acc[i] = (f32x4){0.f, 0.f, 0.f, 0.f};
#pragma unroll 4
        for (int d = 0; d < 128; ++d) {
            const f32x4 av = *(const LAS f32x4*)(skT + d * 132 + 4 * tn), bv = *(const LAS f32x4*)(wqT + d * 68 + 4 * tk);
            acc[0] += av.x * bv; acc[1] += av.y * bv; acc[2] += av.z * bv; acc[3] += av.w * bv;
        }
        bf16* WT = (bf16*)(a.ws + WS_WCOMB) + (size_t)l * 2048 * 1024;
#pragma unroll
        for (int i = 0; i < 4; ++i) { u32x2 o; o.x = pk2(acc[i].x, acc[i].y); o.y = pk2(acc[i].z, acc[i].w);
            *(u32x2*)(WT + (size_t)(hp * 128 + 4 * tn + i) * 1024 + kb * 64 + 4 * tk) = o; }
        __syncthreads();
    }
}

__device__ __forceinline__ void p0_weights(const Frame& F, const Args& a) {
    LAS float* scr = (LAS float*)(F.lds + RING_OFF + F.wave * 16384);
    bf16* WinT = (bf16*)(a.ws + WS_WIN); bf16* WuqT = (bf16*)(a.ws + WS_WUQ); bf16* WukvT = (bf16*)(a.ws + WS_WUKV);
    bf16* WoabT = (bf16*)(a.ws + WS_WOAB); bf16* WincT = (bf16*)(a.ws + WS_WINC); bf16* WocT = (bf16*)(a.ws + WS_WOC);
    constexpr int I_IN = 16 * 61, I_UQ = 4 * 24, I_UKV = 2 * 32, I_OAB = 16 * 32, I_INC = 16 * 96, I_OC = 16 * 32;
    constexpr int NITEMS = I_IN + I_UQ + I_UKV + I_OAB + I_INC + I_OC;
    for (int it = F.gw; it < NITEMS; it += F.NGW) {
        int r = it;
        if (r < I_IN) { transpose_item(a.w_in_ab, 1024, AB_IN, WinT, nullptr, scr, r, F.lane); continue; } r -= I_IN;
        if (r < I_UQ) { transpose_item(a.mla_w_uq, 256, 768, WuqT, a.mla_q_norm_g, scr, r, F.lane); continue; } r -= I_UQ;
        if (r < I_UKV) { transpose_item(a.mla_w_ukv, 128, 1024, WukvT, a.mla_kv_norm_g, scr, r, F.lane); continue; } r -= I_UKV;
        if (r < I_OAB) { transpose_item(a.w_out_ab, 1024, 1024, WoabT, nullptr, scr, r, F.lane); continue; } r -= I_OAB;
        if (r < I_INC) { transpose_item(a.w_in_c, 1024, 3072, WincT, nullptr, scr, r, F.lane); continue; } r -= I_INC;
        transpose_item(a.w_out_c, 1024, 1024, WocT, nullptr, scr, r, F.lane);
    }
    { u32x4* z = (u32x4*)(WinT + (size_t)AB_IN * 1024); const int n16 = (AB_INP - AB_IN) * 1024 * 2 / 16;
      for (int i = F.vcu * NTHR + F.tid; i < n16; i += F.G * NTHR) z[i] = (u32x4){0u, 0u, 0u, 0u}; }
}

__device__ __forceinline__ void norm_rows_adaln(const Frame& F, const float* src, const float* g, const float* modl, int sh_off, int sc_off, bf16* dst) {
    for (int row = F.gw; row < T; row += F.NGW) {
        const int b = row >> 12;
        const f32x4* xr = (const f32x4*)(src + (size_t)row * D) + F.lane;
        f32x4 v[4]; float s = 0.f;
#pragma unroll
        for (int j = 0; j < 4; ++j) { v[j] = xr[64 * j]; s += (v[j].x * v[j].x + v[j].y * v[j].y) + (v[j].z * v[j].z + v[j].w * v[j].w); }
        const float rstd = 1.f / sqrtf(wave_sum(s, F.lane) * (1.f / D) + NORM_EPS);
        const f32x4* gp = (const f32x4*)g + F.lane; const f32x4* scp = (const f32x4*)(modl + (size_t)b * 6144 + sc_off) + F.lane; const f32x4* shp = (const f32x4*)(modl + (size_t)b * 6144 + sh_off) + F.lane;
        u32x2* o8 = (u32x2*)(dst + (size_t)row * D) + F.lane;
#pragma unroll
        for (int j = 0; j < 4; ++j) { const f32x4 gg = gp[64 * j], sc = scp[64 * j], sh = shp[64 * j];
            const f32x4 y = (v[j] * rstd) * gg * (sc + 1.0f) + sh;
            u32x2 o; o.x = pk2(y.x, y.y); o.y = pk2(y.z, y.w); o8[64 * j] = o; }
    }
}
__device__ __forceinline__ void norm_rows_final(const Frame& F, const float* src, const float* g, float* dst) {
    for (int row = F.gw; row < T; row += F.NGW) {
        const f32x4* xr = (const f32x4*)(src + (size_t)row * D) + F.lane;
        f32x4 v[4]; float s = 0.f;
#pragma unroll
        for (int j = 0; j < 4; ++j) { v[j] = xr[64 * j]; s += (v[j].x * v[j].x + v[j].y * v[j].y) + (v[j].z * v[j].z + v[j].w * v[j].w); }
        const float rstd = 1.f / sqrtf(wave_sum(s, F.lane) * (1.f / D) + NORM_EPS);
        const f32x4* gp = (const f32x4*)g + F.lane; f32x4* o = (f32x4*)(dst + (size_t)row * D) + F.lane;
#pragma unroll
        for (int j = 0; j < 4; ++j) o[64 * j] = (v[j] * rstd) * gp[64 * j];
    }
}


namespace pg8 {
constexpr int BM = 256, BK = 64, HALF = 128, HTB = HALF * BK * 2, STAGE_BYTES = 8 * HTB, NXCD = 8, WGM = 8;
__host__ __device__ __forceinline__ int lds_byte(int r, int c) { const int st = (r >> 4) * 2 + (c >> 5), rr = r & 15, cc = c & 31, ob = rr * 64 + cc * 2; return st * 1024 + (ob ^ (((ob >> 9) & 1) << 5)); }
__host__ __device__ __forceinline__ void stage_rc(int b, int& R, int& C) { const int st = b / 1024, sb = b % 1024, swz = sb ^ (((sb >> 9) & 1) << 5); R = (st >> 1) * 16 + swz / 64; C = (st & 1) * 32 + (swz % 64) / 2; }
__host__ __device__ __forceinline__ int perm32(int rho) { const int n = rho >> 4, i = rho & 15; return 8 * (i >> 2) + 4 * n + (i & 3); }

struct Unit { int pm, pn; };
struct Gemm { const bf16* A; const bf16* Bt; int M, N, K, lda; };

struct StaticOrder {
    int nM, nN, nwg, G, c;
    __host__ __device__ void init(int M, int N, int G_, int c_) { nM = M / BM; nN = N / BM; nwg = nM * nN; G = G_; c = c_; }
    __host__ __device__ bool next(int i, Unit& u) const {
        const long L = (long)i * G + c; if (L >= nwg) return false;
        int wgid = (int)L; { const int q = nwg / NXCD, r = nwg % NXCD, xcd = wgid % NXCD, off = wgid / NXCD; wgid = (xcd < r ? xcd * (q + 1) : r * (q + 1) + (xcd - r) * q) + off; }
        const int nig = WGM * nN, gid = wgid / nig, fm = gid * WGM, gsz = (nM - fm) < WGM ? (nM - fm) : WGM;
        u.pm = fm + ((wgid % nig) % gsz); u.pn = (wgid % nig) / gsz; return true;
    }
    __device__ __forceinline__ void a_ready(const Unit&) const {}
    __device__ __forceinline__ void done(const Unit&) const {}
};

template <int MODE> struct EpiGen {
    static constexpr bool PERM = true, AFTER_DRAIN = false;
    void* O; int ldc; const float* rscale; const float* base; const float* gate;
    __device__ __forceinline__ void operator()(const f32x4 (&acc)[2][2][4][2], const Unit& u, int wr, int wc, int fr, int fq) const {
        const int row0 = u.pm * BM + wr * 64 + fr, col0 = u.pn * BM + wc * 32 + 8 * fq;
#pragma unroll
        for (int ai = 0; ai < 2; ++ai)
#pragma unroll
            for (int m = 0; m < 4; ++m) {
                const int row = row0 + ai * HALF + m * 16;
                float sc = 1.f; if (MODE == 0 && rscale) sc = rscale[row];
#pragma unroll
                for (int bj = 0; bj < 2; ++bj) {
                    const int col = col0 + bj * HALF;
                    f32x4 v0 = acc[ai][bj][m][0], v1 = acc[ai][bj][m][1];
                    if (MODE == 0) {
                        v0 = v0 * sc; v1 = v1 * sc;
                        u32x4 w; w.x = pk2(v0[0], v0[1]); w.y = pk2(v0[2], v0[3]); w.z = pk2(v1[0], v1[1]); w.w = pk2(v1[2], v1[3]);
                        *(u32x4*)((bf16*)O + (size_t)row * ldc + col) = w;
                    } else if (MODE == 1) {
                        const float* gp = gate + (size_t)(row >> 12) * 6144 + col; const float* bp = base + (size_t)row * ldc + col; float* op = (float*)O + (size_t)row * ldc + col;
                        const f32x4 g0 = *(const f32x4*)gp, g1 = *(const f32x4*)(gp + 4), b0 = *(const f32x4*)bp, b1 = *(const f32x4*)(bp + 4);
                        *(f32x4*)op = b0 + g0 * v0; *(f32x4*)(op + 4) = b1 + g1 * v1;
                    } else {
                        float* op = (float*)O + (size_t)row * ldc + col;
                        *(f32x4*)op = v0; *(f32x4*)(op + 4) = v1;
                    }
                }
            }
    }
};

template <class Epi, class Sched, bool ALIGN_EPI = true>
__device__ __forceinline__ void gemm_phase(LAS uchar* lds, const Gemm g, const Sched& S, const Epi& E, int tid, int wid) {
    const int lane = tid & 63, wr = wid >> 2, wc = wid & 3, fr = lane & 15, fq = lane >> 4;
    const int K = g.K, nt = K / BK, lda = g.lda;
    unsigned voffA[2], voffB[2];
#pragma unroll
    for (int i = 0; i < 2; ++i) { int R, C; stage_rc(tid * 16 + i * 8192, R, C); const int Rb = Epi::PERM ? ((R & ~31) + perm32(R & 31)) : R;
        voffA[i] = (unsigned)(R * lda + C) * 2u; voffB[i] = (unsigned)(Rb * K + C) * 2u; }
    const size_t kstep = (size_t)(BK * 2);
    const size_t hstepA = (size_t)HALF * lda * 2, hstepB = (size_t)HALF * K * 2;
    const size_t tstepA = 2 * hstepA, tstepB = 2 * hstepB;
    const unsigned ldsw = (unsigned)wid * 1024u;
    const int aoff = lds_byte(wr * 64 + fr, fq * 8), boff = lds_byte(wc * 32 + fr, fq * 8);
#define PG8_SA(b, h) (((b) * 2 + (h)) * HTB)
#define PG8_SB(b, h) ((4 + (b) * 2 + (h)) * HTB)
#define PG8_STAGE(bufoff, gbase, voff) do { _Pragma("unroll") for (int _i = 0; _i < 2; ++_i) \
        __builtin_amdgcn_global_load_lds((const unsigned*)((const char*)(gbase) + (voff)[_i]), (LAS unsigned*)(lds + (bufoff) + ldsw + _i * 8192), 16, 0, 0); } while (0)
#define PG8_LDA(dst, b, h) do { _Pragma("unroll") for (int m = 0; m < 4; ++m) _Pragma("unroll") for (int k = 0; k < 2; ++k) dst[m][k] = *(const LAS bf16x8*)(lds + PG8_SA(b, h) + aoff + m * 2048 + k * 1024); } while (0)
#define PG8_LDB(dst, b, h) do { _Pragma("unroll") for (int n = 0; n < 2; ++n) _Pragma("unroll") for (int k = 0; k < 2; ++k) dst[n][k] = *(const LAS bf16x8*)(lds + PG8_SB(b, h) + boff + n * 2048 + k * 1024); } while (0)
#define PG8_MMA(ai, bj, At, Bt) do { __builtin_amdgcn_s_setprio(1); _Pragma("unroll") for (int m = 0; m < 4; ++m) _Pragma("unroll") for (int n = 0; n < 2; ++n) _Pragma("unroll") for (int k = 0; k < 2; ++k) \
        acc[ai][bj][m][n] = __builtin_amdgcn_mfma_f32_16x16x32_bf16(Bt[n][k], At[m][k], acc[ai][bj][m][n], 0, 0, 0); __builtin_amdgcn_s_setprio(0); } while (0)
#define PG8_WAIT_V(n) asm volatile("s_waitcnt vmcnt(" #n ")" ::: "memory")
#define PG8_WAIT_L(n) asm volatile("s_waitcnt lgkmcnt(" #n ")" ::: "memory")
#define PG8_BAR __builtin_amdgcn_s_barrier()
#define PG8_SCHED __builtin_amdgcn_sched_barrier(0)
    Unit cur, nxt; int ui = 0;
    if (!S.next(0, cur)) return;
    f32x4 acc[2][2][4][2];
#pragma unroll
    for (int a = 0; a < 2; ++a)
#pragma unroll
        for (int b = 0; b < 2; ++b)
#pragma unroll
            for (int m = 0; m < 4; ++m)
#pragma unroll
                for (int n = 0; n < 2; ++n) acc[a][b][m][n] = (f32x4){0.f, 0.f, 0.f, 0.f};
    bf16x8 At[4][2], B0[2][2], B1[2][2];
    const char* cA = (const char*)g.A + (size_t)cur.pm * tstepA; const char* cB = (const char*)g.Bt + (size_t)cur.pn * tstepB;
    S.a_ready(cur);
    PG8_STAGE(PG8_SB(0, 0), cB, voffB); PG8_STAGE(PG8_SB(0, 1), cB + hstepB, voffB); PG8_STAGE(PG8_SA(0, 0), cA, voffA); PG8_STAGE(PG8_SA(0, 1), cA + hstepA, voffA);
    if (wr == 1) PG8_BAR;
    PG8_WAIT_V(2); PG8_BAR;
    PG8_STAGE(PG8_SB(1, 0), cB + kstep, voffB); PG8_STAGE(PG8_SA(1, 0), cA + kstep, voffA); PG8_STAGE(PG8_SB(1, 1), cB + hstepB + kstep, voffB);
    PG8_WAIT_V(6); PG8_BAR;
    for (;;) {
        const bool has_next = S.next(ui + 1, nxt);
        const char* nA = has_next ? (const char*)g.A + (size_t)nxt.pm * tstepA : cA; const char* nB = has_next ? (const char*)g.Bt + (size_t)nxt.pn * tstepB : cB;
        for (int t = 0; t < nt; t += 2) {
            const bool last = (t == nt - 2);
            const char* a1 = cA + (size_t)(t + 1) * kstep;
            const char* a2 = last ? nA : cA + (size_t)(t + 2) * kstep; const char* b2 = last ? nB : cB + (size_t)(t + 2) * kstep;
            const char* a3 = a2 + kstep; const char* b3 = b2 + kstep;
            if (last && has_next) S.a_ready(nxt);
            PG8_LDB(B0, 0, 0); PG8_LDB(B1, 0, 1); PG8_SCHED; PG8_LDA(At, 0, 0); PG8_STAGE(PG8_SA(1, 1), a1 + hstepA, voffA);
            PG8_WAIT_V(8); PG8_WAIT_L(0); PG8_BAR; PG8_MMA(0, 0, At, B0); PG8_MMA(0, 1, At, B1); PG8_BAR; PG8_SCHED;
            PG8_LDA(At, 0, 1); PG8_STAGE(PG8_SB(0, 0), b2, voffB); PG8_STAGE(PG8_SB(0, 1), b2 + hstepB, voffB); PG8_STAGE(PG8_SA(0, 0), a2, voffA);
            PG8_WAIT_V(8); PG8_WAIT_L(0); PG8_BAR; PG8_MMA(1, 0, At, B0); PG8_MMA(1, 1, At, B1); PG8_BAR; PG8_SCHED;
            PG8_LDB(B0, 1, 0); PG8_LDB(B1, 1, 1); PG8_SCHED; PG8_LDA(At, 1, 0); PG8_STAGE(PG8_SA(0, 1), a2 + hstepA, voffA);
            PG8_WAIT_V(8); PG8_WAIT_L(0); PG8_BAR; PG8_MMA(0, 0, At, B0); PG8_MMA(0, 1, At, B1); PG8_BAR; PG8_SCHED;
            PG8_LDA(At, 1, 1); PG8_STAGE(PG8_SB(1, 0), b3, voffB); PG8_STAGE(PG8_SB(1, 1), b3 + hstepB, voffB); PG8_STAGE(PG8_SA(1, 0), a3, voffA);
            PG8_WAIT_V(8); PG8_WAIT_L(0); PG8_BAR; PG8_MMA(1, 0, At, B0); PG8_MMA(1, 1, At, B1); PG8_BAR; PG8_SCHED;
        }
        if constexpr (ALIGN_EPI) { if (wr == 0) PG8_BAR; }
        E(acc, cur, wr, wc, fr, fq); S.done(cur);
        if (!has_next) break;
#pragma unroll
        for (int a = 0; a < 2; ++a)
#pragma unroll
            for (int b = 0; b < 2; ++b)
#pragma unroll
                for (int m = 0; m < 4; ++m)
#pragma unroll
                    for (int n = 0; n < 2; ++n) acc[a][b][m][n] = (f32x4){0.f, 0.f, 0.f, 0.f};
        cur = nxt; cA = nA; cB = nB; ++ui;
        if constexpr (ALIGN_EPI) { if (wr == 1) PG8_BAR; }
    }
    PG8_WAIT_V(0);
    if constexpr (!ALIGN_EPI) { if (wr == 0) PG8_BAR; }
    PG8_BAR;
#undef PG8_SA
#undef PG8_SB
#undef PG8_STAGE
#undef PG8_LDA
#undef PG8_LDB
#undef PG8_MMA
#undef PG8_WAIT_V
#undef PG8_WAIT_L
#undef PG8_BAR
#undef PG8_SCHED
}
}


#ifndef CHECKS
#define CHECKS 0
#endif
constexpr int CW_CHK = 64;
__device__ __forceinline__ float bf2f(bf16 v) { return __builtin_bit_cast(float, (unsigned)v << 16); }
__device__ __forceinline__ bf16 f2bf(float v) { return (bf16)(pk2(v, 0.f) & 0xffffu); }
__device__ __forceinline__ void gemm_check(const Frame& F, const Args& a, const bf16* A, int lda, const bf16* Bt, int K, int N, const void* O, int ldc, int mode,
                                           const float* rscale, const float* base, const float* gate, int k) {
    unsigned s = (unsigned)(F.vcu * NTHR + F.tid);
    const int row = (int)((s * 7919u) % (unsigned)T), col = (int)((s * 104729u) % (unsigned)N);
    float ref = 0.f;
    for (int i = 0; i < K; ++i) ref += bf2f(A[(size_t)row * lda + i]) * bf2f(Bt[(size_t)col * K + i]);
    bool bad;
    if (mode == 0) { const float v = bf2f(((const bf16*)O)[(size_t)row * ldc + col]); const float e = ref * (rscale ? rscale[row] : 1.f); bad = !(fabsf(v - e) <= 0.01f * fabsf(e) + 0.02f); }
    else if (mode == 1) { const float v = ((const float*)O)[(size_t)row * ldc + col]; const float b0 = base[(size_t)row * ldc + col]; const float e = b0 + gate[(size_t)(row >> 12) * 6144 + col] * ref;
        bad = !(fabsf(v - e) <= 1e-3f * (fabsf(b0) + fabsf(e)) + 1e-3f); }
    else { const float v = ((const float*)O)[(size_t)row * ldc + col]; bad = !(fabsf(v - ref) <= 1e-3f * fabsf(ref) + 1e-3f); }
    if (bad) atomicAdd((unsigned*)(a.ws + WS_CTL) + CW_CHK + k, 1u);
}

__device__ __forceinline__ void p3_post(const Frame& F, const Args& a) {
    bf16* proj = (bf16*)(a.ws + WS_PROJ);
    float* rq = (float*)(a.ws + WS_RSTDQ); float* rkv = (float*)(a.ws + WS_RSTDKV);
    const float* ropeA = (const float*)(a.ws + WS_ROPEA); const float* ropeB = (const float*)(a.ws + WS_ROPEB);
    const int lane = F.lane;
    for (int t = F.gw; t < T; t += F.NGW) {
        bf16* row = proj + (size_t)t * AB_INP;
        const u32x2 q = *(const u32x2*)(row + C_QLAT + 4 * lane);
        float s = bf_lo(q.x) * bf_lo(q.x) + bf_hi(q.x) * bf_hi(q.x) + bf_lo(q.y) * bf_lo(q.y) + bf_hi(q.y) * bf_hi(q.y);
        const unsigned kv = *(const unsigned*)(row + C_KVLAT + 2 * lane);
        float s2 = bf_lo(kv) * bf_lo(kv) + bf_hi(kv) * bf_hi(kv);
        s = wave_sum(s, lane); s2 = wave_sum(s2, lane);
        if (lane == 0) { rq[t] = 1.f / sqrtf(s * (1.f / 256.f) + NORM_EPS); rkv[t] = 1.f / sqrtf(s2 * (1.f / 128.f) + NORM_EPS); }
        if (lane < 16) {
            const float x1 = bf2f(row[C_KPE + lane]), x2 = bf2f(row[C_KPE + 16 + lane]);
            const float cs = ropeA[(size_t)t * 32 + lane], sn = ropeA[(size_t)t * 32 + 16 + lane];
            row[C_KPE + lane] = f2bf(x1 * cs - x2 * sn); row[C_KPE + 16 + lane] = f2bf(x2 * cs + x1 * sn);
        }
        { const int c0 = C_BK + (lane >> 2) * 32 + (lane & 3);
          const float x1 = bf2f(row[c0]), x2 = bf2f(row[c0 + 4]);
          const float cs = ropeB[(size_t)t * 8 + (lane & 3)], sn = ropeB[(size_t)t * 8 + 4 + (lane & 3)];
          row[c0] = f2bf(x1 * cs - x2 * sn); row[c0 + 4] = f2bf(x2 * cs + x1 * sn); }
    }
}


namespace att {
constexpr int KST = 208, VST = 192, KTILE = 64 * KST, VTILE = 64 * VST;
constexpr int OFF_K = 0, OFF_V = 2 * KTILE, OFF_BIAS = OFF_V + 2 * VTILE, ATT_LDS = OFF_BIAS + 272 * 4;
constexpr float LOG2E = 1.4426950408889634f;
#define MFMA32(a, b, c) __builtin_amdgcn_mfma_f32_32x32x16_bf16((a), (b), (c), 0, 0, 0)
struct St { f32x16 o0, o1; float m, l; };
__device__ __forceinline__ void st_init(St& s) {
#pragma unroll
    for (int i = 0; i < 16; ++i) { s.o0[i] = 0.f; s.o1[i] = 0.f; }
    s.m = -1e30f; s.l = 0.f;
}
__device__ __forceinline__ bf16x8 pack8(float a0, float a1, float a2, float a3, float a4, float a5, float a6, float a7) {
    u32x4 p; p.x = pk2(a0, a1); p.y = pk2(a2, a3); p.z = pk2(a4, a5); p.w = pk2(a6, a7); return __builtin_bit_cast(bf16x8, p);
}
template <int KS0, int NKS>
__device__ __forceinline__ void qk_tile(const LAS uchar* Kt, int lane, const bf16x8* qf, f32x16& s0, f32x16& s1) {
    const LAS uchar* kp = Kt + (lane & 31) * KST + (lane >> 5) * 16 + KS0 * 32;
#pragma unroll
    for (int i = 0; i < 16; ++i) { s0[i] = 0.f; s1[i] = 0.f; }
#pragma unroll
    for (int ks = 0; ks < NKS; ++ks) {
        const bf16x8 k0 = *(const LAS bf16x8*)(kp + ks * 32), k1 = *(const LAS bf16x8*)(kp + 32 * KST + ks * 32);
        s0 = MFMA32(k0, qf[ks], s0); s1 = MFMA32(k1, qf[ks], s1);
    }
}
template <bool PRE>
__device__ __forceinline__ void softmax_tile(f32x16& s0, f32x16& s1, float c, St& st, bf16x8 (&pf)[2][2], int lane) {
    float mx = s0[0];
#pragma unroll
    for (int i = 1; i < 16; ++i) mx = fmaxf(mx, s0[i]);
#pragma unroll
    for (int i = 0; i < 16; ++i) mx = fmaxf(mx, s1[i]);
    mx = fmaxf(mx, shx(mx, 32, lane));
    const float mnew = fmaxf(st.m, PRE ? mx : mx * c);
    const float alpha = __builtin_amdgcn_exp2f(st.m - mnew);
    st.m = mnew;
    float rs = 0.f;
#pragma unroll
    for (int i = 0; i < 16; ++i) { const float p = __builtin_amdgcn_exp2f(PRE ? (s0[i] - mnew) : __builtin_fmaf(s0[i], c, -mnew)); s0[i] = p; rs += p; }
#pragma unroll
    for (int i = 0; i < 16; ++i) { const float p = __builtin_amdgcn_exp2f(PRE ? (s1[i] - mnew) : __builtin_fmaf(s1[i], c, -mnew)); s1[i] = p; rs += p; }
    st.l = st.l * alpha + rs;
    st.o0 = st.o0 * alpha; st.o1 = st.o1 * alpha;
    pf[0][0] = pack8(s0[0], s0[1], s0[2], s0[3], s0[4], s0[5], s0[6], s0[7]);
    pf[0][1] = pack8(s0[8], s0[9], s0[10], s0[11], s0[12], s0[13], s0[14], s0[15]);
    pf[1][0] = pack8(s1[0], s1[1], s1[2], s1[3], s1[4], s1[5], s1[6], s1[7]);
    pf[1][1] = pack8(s1[8], s1[9], s1[10], s1[11], s1[12], s1[13], s1[14], s1[15]);
}
__device__ __forceinline__ void pv_tile(const LAS uchar* Vt, int lane, const bf16x8 (&pf)[2][2], St& st) {
    const int hh = lane >> 5, q = (lane & 15) >> 2, p = lane & 3, blk = (lane >> 4) & 1;
    const LAS uchar* vb = Vt + (4 * hh + q) * VST + (16 * blk + 4 * p) * 2;
#pragma unroll
    for (int kh = 0; kh < 2; ++kh)
#pragma unroll
        for (int s = 0; s < 2; ++s) {
            const LAS uchar* vp = vb + (32 * kh + 16 * s) * VST;
            const s16x4 lo0 = __builtin_amdgcn_ds_read_tr16_b64_v4i16((LAS s16x4*)(vp)), hi0 = __builtin_amdgcn_ds_read_tr16_b64_v4i16((LAS s16x4*)(vp + 8 * VST));
            const s16x4 lo1 = __builtin_amdgcn_ds_read_tr16_b64_v4i16((LAS s16x4*)(vp + 64)), hi1 = __builtin_amdgcn_ds_read_tr16_b64_v4i16((LAS s16x4*)(vp + 8 * VST + 64));
            const bf16x8 v0 = __builtin_shufflevector(lo0, hi0, 0, 1, 2, 3, 4, 5, 6, 7), v1 = __builtin_shufflevector(lo1, hi1, 0, 1, 2, 3, 4, 5, 6, 7);
            st.o0 = MFMA32(v0, pf[kh][s], st.o0); st.o1 = MFMA32(v1, pf[kh][s], st.o1);
        }
}
struct Tensors { const bf16* Q; const bf16* KV; const bf16* PROJ; const bf16* QKV; bf16* O; const float* ropeA; const float* ropeB; const float* rel_bias; const float* hng; float lam; };

template <int MODE>
__device__ __forceinline__ void attn_unit(const Frame& F, LAS uchar* lds, const Tensors& X, int b, int head, int qt) {
    int tid = F.tid; asm volatile("" : "+v"(tid));
    const int lane = tid & 63, wave = F.wave, hh = lane >> 5;
    constexpr int NQF = MODE == 0 ? 6 : 4;
    const int qrow = b * SEQ + 256 * qt + 32 * wave + (lane & 31);
    bf16x8 qf[NQF];
    {
        const bf16* qp = MODE == 0 ? X.Q + (size_t)qrow * 768 + head * 96 + 8 * hh : MODE == 1 ? X.PROJ + (size_t)qrow * AB_INP + C_BQ + head * 64 + 8 * hh : X.QKV + (size_t)qrow * 3072 + head * 64 + 8 * hh;
#pragma unroll
        for (int ks = 0; ks < NQF; ++ks) qf[ks] = *(const bf16x8*)(qp + 16 * ks);
        if (MODE == 0) {
            const float* rp = X.ropeA + (size_t)qrow * 32 + 8 * hh;
            const f32x4 c0 = *(const f32x4*)rp, c1 = *(const f32x4*)(rp + 4), s0 = *(const f32x4*)(rp + 16), s1 = *(const f32x4*)(rp + 20);
            float cs[8] = {c0.x, c0.y, c0.z, c0.w, c1.x, c1.y, c1.z, c1.w}, sn[8] = {s0.x, s0.y, s0.z, s0.w, s1.x, s1.y, s1.z, s1.w};
            float o1[8], o2[8];
#pragma unroll
            for (int j = 0; j < 8; ++j) { const float x1 = bf2f((bf16)qf[4][j]), x2 = bf2f((bf16)qf[5][j]); o1[j] = x1 * cs[j] - x2 * sn[j]; o2[j] = x2 * cs[j] + x1 * sn[j]; }
            qf[4] = pack8(o1[0], o1[1], o1[2], o1[3], o1[4], o1[5], o1[6], o1[7]); qf[5] = pack8(o2[0], o2[1], o2[2], o2[3], o2[4], o2[5], o2[6], o2[7]);
        }
        if (MODE == 1) {
            const float* rp = X.ropeB + (size_t)qrow * 8;
            const f32x4 c = *(const f32x4*)rp, s = *(const f32x4*)(rp + 4);
            const float cs[4] = {c.x, c.y, c.z, c.w}, sn[4] = {s.x, s.y, s.z, s.w};
#pragma unroll
            for (int f = 0; f < 4; f += 2) {
                float v[8];
#pragma unroll
                for (int j = 0; j < 8; ++j) v[j] = bf2f((bf16)qf[f][j]);
                float o[8];
#pragma unroll
                for (int j = 0; j < 4; ++j) { o[j] = v[j] * cs[j] - v[j + 4] * sn[j]; o[j + 4] = v[j + 4] * cs[j] + v[j] * sn[j]; }
                const bf16x8 r = pack8(o[0], o[1], o[2], o[3], o[4], o[5], o[6], o[7]);
                if (hh == 0) qf[f] = r;
            }
        }
    }
    const int key = tid >> 3, ch = tid & 7;
    const char* kvbase = (const char*)(MODE == 0 ? X.KV : MODE == 1 ? X.PROJ : X.QKV);
    unsigned koff, voff, poff = 0u, tstride, pstride = 0u;
    if (MODE == 0) { koff = (unsigned)((b * SEQ + key) * 1024 + head * 128 + ch * 8) * 2u; voff = koff + 128u; tstride = 64u * 1024u * 2u;
                     poff = (unsigned)((b * SEQ + (tid >> 2)) * AB_INP + C_KPE + (tid & 3) * 8) * 2u; pstride = 64u * AB_INP * 2u; }
    else if (MODE == 1) { koff = (unsigned)((b * SEQ + key) * AB_INP + C_BK + head * 64 + ch * 8) * 2u; voff = koff + (unsigned)(C_BV - C_BK) * 2u; tstride = 64u * AB_INP * 2u; }
    else { koff = (unsigned)((b * SEQ + key) * 3072 + 1024 + head * 64 + ch * 8) * 2u; voff = koff + 2048u; tstride = 64u * 3072u * 2u; }
    const char* pbase = (const char*)X.PROJ;
    const int kdst = key * KST + ch * 16, vdst = key * VST + ch * 16, pdst = (tid >> 2) * KST + 128 + (tid & 3) * 16;
    const int jlo = MODE == 2 ? (4 * qt - 8 > 0 ? 4 * qt - 8 : 0) : 0, jhi = 4 * qt + 3, cw = 4 * qt + (wave >> 1);
    const float c = (MODE == 0 ? 0.10206207261596575f : MODE == 1 ? 0.17677669529663687f : 0.125f) * LOG2E;
    LAS float* biasT = (LAS float*)(lds + OFF_BIAS);
    if (MODE == 2) { if (tid < 257) biasT[tid] = X.rel_bias[head * 257 + tid] * LOG2E; }
    St st1, st2; st_init(st1); if (MODE == 1) st_init(st2);
    u32x4 rk, rv, rp4;
    rk = *(const u32x4*)(kvbase + (koff + (unsigned)jlo * tstride)); rv = *(const u32x4*)(kvbase + (voff + (unsigned)jlo * tstride));
    if (MODE == 0 && tid < 256) rp4 = *(const u32x4*)(pbase + (poff + (unsigned)jlo * pstride));
    *(LAS u32x4*)(lds + OFF_K + kdst) = rk; *(LAS u32x4*)(lds + OFF_V + vdst) = rv;
    if (MODE == 0 && tid < 256) *(LAS u32x4*)(lds + OFF_K + pdst) = rp4;
    __syncthreads();
    for (int j = jlo; j <= jhi; ++j) {
        const int stg = (j - jlo) & 1;
        if (j < jhi) { rk = *(const u32x4*)(kvbase + (koff + (unsigned)(j + 1) * tstride)); rv = *(const u32x4*)(kvbase + (voff + (unsigned)(j + 1) * tstride));
                       if (MODE == 0 && tid < 256) rp4 = *(const u32x4*)(pbase + (poff + (unsigned)(j + 1) * pstride)); }
        const bool active = (j <= cw) && (MODE != 2 || j >= cw - 8);
        if (active) {
            const LAS uchar* Kt = lds + OFF_K + stg * KTILE; const LAS uchar* Vt = lds + OFF_V + stg * VTILE;
            f32x16 s0, s1; bf16x8 pf[2][2];
            if (MODE == 0) { qk_tile<0, 6>(Kt, lane, qf, s0, s1); softmax_tile<false>(s0, s1, c, st1, pf, lane); pv_tile(Vt, lane, pf, st1); }
            else if (MODE == 1) {
                qk_tile<0, 2>(Kt, lane, qf, s0, s1); softmax_tile<false>(s0, s1, c, st1, pf, lane); pv_tile(Vt, lane, pf, st1);
                qk_tile<2, 2>(Kt, lane, qf + 2, s0, s1); softmax_tile<false>(s0, s1, c, st2, pf, lane); pv_tile(Vt, lane, pf, st2);
            } else {
                qk_tile<0, 4>(Kt, lane, qf, s0, s1);
                if (cw - j >= 3) { const float bc = biasT[256];
#pragma unroll
                    for (int i = 0; i < 16; ++i) { s0[i] = __builtin_fmaf(s0[i], c, bc); s1[i] = __builtin_fmaf(s1[i], c, bc); } }
                else { const int qoff = 256 * qt + 32 * wave + (lane & 31) - 64 * j + 128 - 4 * hh;
#pragma unroll
                    for (int i = 0; i < 16; ++i) { const int kk = (i & 3) + 8 * (i >> 2);
                        int i0 = qoff - kk; i0 = i0 < 0 ? 0 : (i0 > 256 ? 256 : i0); int i1 = qoff - kk - 32; i1 = i1 < 0 ? 0 : (i1 > 256 ? 256 : i1);
                        s0[i] = __builtin_fmaf(s0[i], c, biasT[i0]); s1[i] = __builtin_fmaf(s1[i], c, biasT[i1]); } }
                softmax_tile<true>(s0, s1, 1.f, st1, pf, lane); pv_tile(Vt, lane, pf, st1);
            }
        }
        if (j < jhi) { *(LAS u32x4*)(lds + OFF_K + (stg ^ 1) * KTILE + kdst) = rk; *(LAS u32x4*)(lds + OFF_V + (stg ^ 1) * VTILE + vdst) = rv;
                       if (MODE == 0 && tid < 256) *(LAS u32x4*)(lds + OFF_K + (stg ^ 1) * KTILE + pdst) = rp4; }
        __syncthreads();
    }
    if (MODE != 1) {
        const float inv = 1.f / (st1.l + shx(st1.l, 32, lane));
        bf16* op = X.O + (size_t)qrow * 1024 + head * 64 + 4 * hh;
#pragma unroll
        for (int g = 0; g < 4; ++g) {
            u32x2 w0; w0.x = pk2(st1.o0[4 * g] * inv, st1.o0[4 * g + 1] * inv); w0.y = pk2(st1.o0[4 * g + 2] * inv, st1.o0[4 * g + 3] * inv); *(u32x2*)(op + 8 * g) = w0;
            u32x2 w1; w1.x = pk2(st1.o1[4 * g] * inv, st1.o1[4 * g + 1] * inv); w1.y = pk2(st1.o1[4 * g + 2] * inv, st1.o1[4 * g + 3] * inv); *(u32x2*)(op + 32 + 8 * g) = w1;
        }
    } else {
        const float i1 = 1.f / (st1.l + shx(st1.l, 32, lane)), i2 = X.lam / (st2.l + shx(st2.l, 32, lane));
        float ss = 0.f;
#pragma unroll
        for (int i = 0; i < 16; ++i) { st1.o0[i] = st1.o0[i] * i1 - st2.o0[i] * i2; st1.o1[i] = st1.o1[i] * i1 - st2.o1[i] * i2; ss += st1.o0[i] * st1.o0[i] + st1.o1[i] * st1.o1[i]; }
        ss += shx(ss, 32, lane);
        const float r = 0.8f / sqrtf(ss * (1.f / 64.f) + NORM_EPS);
        bf16* op = X.O + (size_t)qrow * 1024 + 512 + head * 64 + 4 * hh;
        const float* gp = X.hng + 4 * hh;
#pragma unroll
        for (int g = 0; g < 4; ++g) {
            const f32x4 g0 = *(const f32x4*)(gp + 8 * g), g1 = *(const f32x4*)(gp + 32 + 8 * g);
            u32x2 w0; w0.x = pk2(st1.o0[4 * g] * r * g0.x, st1.o0[4 * g + 1] * r * g0.y); w0.y = pk2(st1.o0[4 * g + 2] * r * g0.z, st1.o0[4 * g + 3] * r * g0.w); *(u32x2*)(op + 8 * g) = w0;
            u32x2 w1; w1.x = pk2(st1.o1[4 * g] * r * g1.x, st1.o1[4 * g + 1] * r * g1.y); w1.y = pk2(st1.o1[4 * g + 2] * r * g1.z, st1.o1[4 * g + 3] * r * g1.w); *(u32x2*)(op + 32 + 8 * g) = w1;
        }
    }
}
#if CHECKS
template <int MODE>
__device__ __forceinline__ float chk_q(const Tensors& X, int qrow, int head, int sub, int e) {
    if (MODE == 0) { const bf16* qp = X.Q + (size_t)qrow * 768 + head * 96;
        if (e < 64) return bf2f(qp[e]);
        const int i = (e - 64) & 15; const float cs = X.ropeA[(size_t)qrow * 32 + i], sn = X.ropeA[(size_t)qrow * 32 + 16 + i]; const float x1 = bf2f(qp[64 + i]), x2 = bf2f(qp[80 + i]);
        return bf2f(f2bf(e < 80 ? x1 * cs - x2 * sn : x2 * cs + x1 * sn)); }
    if (MODE == 1) { const bf16* qp = X.PROJ + (size_t)qrow * AB_INP + C_BQ + head * 64 + sub * 32;
        if (e >= 8) return bf2f(qp[e]);
        const int i = e & 3; const float cs = X.ropeB[(size_t)qrow * 8 + i], sn = X.ropeB[(size_t)qrow * 8 + 4 + i]; const float x1 = bf2f(qp[i]), x2 = bf2f(qp[4 + i]);
        return bf2f(f2bf(e < 4 ? x1 * cs - x2 * sn : x2 * cs + x1 * sn)); }
    return bf2f(X.QKV[(size_t)qrow * 3072 + head * 64 + e]);
}
template <int MODE>
__device__ __forceinline__ float chk_score(const Tensors& X, int b, int q, int qrow, int head, int sub, int kk) {
    const int dq = MODE == 0 ? 96 : MODE == 1 ? 32 : 64; const int krow = b * SEQ + kk; float d = 0.f;
    for (int e = 0; e < dq; ++e) { float kvv;
        if (MODE == 0) kvv = e < 64 ? bf2f(X.KV[(size_t)krow * 1024 + head * 128 + e]) : bf2f(X.PROJ[(size_t)krow * AB_INP + C_KPE + (e - 64)]);
        else if (MODE == 1) kvv = bf2f(X.PROJ[(size_t)krow * AB_INP + C_BK + head * 64 + sub * 32 + e]);
        else kvv = bf2f(X.QKV[(size_t)krow * 3072 + 1024 + head * 64 + e]);
        d += chk_q<MODE>(X, qrow, head, sub, e) * kvv; }
    d *= (MODE == 0 ? 0.10206207261596575f : MODE == 1 ? 0.17677669529663687f : 0.125f);
    if (MODE == 2) { int rel = q - kk; rel = rel < -128 ? -128 : (rel > 128 ? 128 : rel); d += X.rel_bias[head * 257 + rel + 128]; }
    return d;
}
template <int MODE>
__device__ __forceinline__ float chk_attn1(const Tensors& X, int b, int q, int head, int sub, int lane) {
    const int qrow = b * SEQ + q, chunk = q >> 6;
    const int klo = MODE == 2 ? (chunk - 8 > 0 ? (chunk - 8) * 64 : 0) : 0, khi = (chunk + 1) * 64;
    float mx = -1e30f;
    for (int k0 = klo; k0 < khi; k0 += 64) mx = fmaxf(mx, chk_score<MODE>(X, b, q, qrow, head, sub, k0 + lane));
#pragma unroll
    for (int o = 1; o < 64; o <<= 1) mx = fmaxf(mx, shx(mx, o, lane));
    float den = 0.f, acc = 0.f;
    for (int k0 = klo; k0 < khi; k0 += 64) {
        const float p = __expf(chk_score<MODE>(X, b, q, qrow, head, sub, k0 + lane) - mx); den += p;
        for (int i = 0; i < 64; ++i) { const float pi = __builtin_bit_cast(float, __builtin_amdgcn_readlane(__builtin_bit_cast(int, p), i)); const int krow = b * SEQ + k0 + i;
            const float vv = MODE == 0 ? bf2f(X.KV[(size_t)krow * 1024 + head * 128 + 64 + lane]) : MODE == 1 ? bf2f(X.PROJ[(size_t)krow * AB_INP + C_BV + head * 64 + lane]) : bf2f(X.QKV[(size_t)krow * 3072 + 2048 + head * 64 + lane]);
            acc += pi * vv; }
    }
    return acc / wave_sum(den, lane);
}
template <int MODE>
__device__ __forceinline__ void attn_check(const Frame& F, const Args& a, const Tensors& X, int k) {
    unsigned s = (unsigned)F.gw; asm volatile("" : "+s"(s));
    const int lane = F.lane;
    const int b = (int)(s % 8u), head = (int)((s / 8u) % (MODE == 2 ? 16u : 8u)), q = (int)((s * 2654435761u) >> 20) & 4095;
    float o = chk_attn1<MODE>(X, b, q, head, 0, lane);
    if (MODE == 1) { o -= X.lam * chk_attn1<MODE>(X, b, q, head, 1, lane); const float ss = wave_sum(o * o, lane); o *= 0.8f / sqrtf(ss / 64.f + NORM_EPS) * X.hng[lane]; }
    const float got = bf2f(X.O[(size_t)(b * SEQ + q) * 1024 + (MODE == 1 ? 512 : 0) + head * 64 + lane]);
    const bool bad = !(fabsf(got - o) <= 0.03f * fabsf(o) + 0.02f);
    if (__ballot(bad) != 0ull && lane == 0) atomicAdd((unsigned*)(a.ws + WS_CTL) + CW_CHK + k, 1u);
}
#endif
}


namespace peer {
constexpr int OFF_TAB = 16384;
__device__ __forceinline__ unsigned mono(float f) { const unsigned u = __builtin_bit_cast(unsigned, f); return u ^ ((unsigned)((int)u >> 31) | 0x80000000u); }
__device__ __forceinline__ float demono(unsigned k) { const unsigned u = (k & 0x80000000u) ? (k ^ 0x80000000u) : ~k; return __builtin_bit_cast(float, u); }
__device__ __forceinline__ unsigned umax(unsigned a, unsigned b) { return a > b ? a : b; }
__device__ __forceinline__ unsigned umin(unsigned a, unsigned b) { return a < b ? a : b; }
__device__ __forceinline__ unsigned shxu(unsigned v, int mask, int lane) { return (unsigned)__builtin_amdgcn_ds_bpermute((lane ^ mask) << 2, (int)v); }
template <int N> __device__ __forceinline__ void bitonic_merge_desc(unsigned (&a)[N]) {
#pragma unroll
    for (int j = N / 2; j > 0; j >>= 1)
#pragma unroll
        for (int i = 0; i < N; ++i) { const int l = i ^ j; if (l > i) { const unsigned hi = umax(a[i], a[l]), lo = umin(a[i], a[l]); a[i] = hi; a[l] = lo; } }
}
template <int N> __device__ __forceinline__ void bitonic_sort_desc(unsigned (&a)[N]) {
#pragma unroll
    for (int k = 2; k <= N; k <<= 1)
#pragma unroll
        for (int j = k >> 1; j > 0; j >>= 1)
#pragma unroll
            for (int i = 0; i < N; ++i) { const int l = i ^ j; if (l > i) { const bool desc = ((i & k) == 0) || (k == N);
                const unsigned hi = umax(a[i], a[l]), lo = umin(a[i], a[l]); a[i] = desc ? hi : lo; a[l] = desc ? lo : hi; } }
}
__device__ __forceinline__ void merge_partner16(unsigned (&a)[16], int mask, int lane) {
    unsigned p[16];
#pragma unroll
    for (int i = 0; i < 16; ++i) p[i] = shxu(a[i], mask, lane);
#pragma unroll
    for (int i = 0; i < 16; ++i) a[i] = umax(a[i], p[15 - i]);
    bitonic_merge_desc<16>(a);
}
__device__ __forceinline__ float dot2bf(unsigned a, unsigned b, float c) { return __builtin_amdgcn_fdot2_f32_bf16(__builtin_bit_cast(bf2v, a), __builtin_bit_cast(bf2v, b), c, false); }
__device__ __forceinline__ float gelu_exact(float z) { return 0.5f * z * (1.f + erff(z * 0.70710678118654752f)); }

struct P { const float* SC; const bf16* H; const bf16* EU; const bf16* EV; float* X; const float* gate_f;
           const float* ng; const float* nsc; const float* nsh;   bf16* Hout; };

template <bool FINAL>
__device__ __forceinline__ void peer_phase(const Frame& F, const P& p) {
    const int lane = F.lane;
    LAS unsigned* keys1 = (LAS unsigned*)(F.lds + RING_OFF + F.wave * 2048);
    LAS unsigned* keys2 = keys1 + 256;
    LAS uchar* tab = F.lds + RING_OFF + OFF_TAB;
    if (F.tid < 64) { int cnt = 0, code = 0xFF;
#pragma unroll
        for (int i = 0; i < 16; ++i) { const int n = 16 / (i + 1); if (F.tid >= cnt && F.tid < cnt + n) code = (i << 4) | (F.tid - cnt); cnt += n; }
        tab[F.tid] = (uchar)code; }
    __syncthreads();
    for (int t = F.gw; t < T; t += F.NGW) {
        const int b = t >> 12;
        unsigned a[16], c2[16];
        { const int g = lane >> 2, i4 = lane & 3; const f32x4* sp = (const f32x4*)(p.SC + (size_t)t * 2048 + g * 128) + i4;
#pragma unroll
          for (int k = 0; k < 4; ++k) { const f32x4 v = sp[4 * k]; const int n0 = 16 * k + 4 * i4;
              a[4 * k + 0] = (mono(v.x) & ~127u) | (unsigned)(127 - (n0 + 0)); a[4 * k + 1] = (mono(v.y) & ~127u) | (unsigned)(127 - (n0 + 1));
              a[4 * k + 2] = (mono(v.z) & ~127u) | (unsigned)(127 - (n0 + 2)); a[4 * k + 3] = (mono(v.w) & ~127u) | (unsigned)(127 - (n0 + 3)); }
#pragma unroll
          for (int k = 4; k < 8; ++k) { const f32x4 v = sp[4 * k]; const int n0 = 16 * k + 4 * i4;
              c2[4 * (k - 4) + 0] = (mono(v.x) & ~127u) | (unsigned)(127 - (n0 + 0)); c2[4 * (k - 4) + 1] = (mono(v.y) & ~127u) | (unsigned)(127 - (n0 + 1));
              c2[4 * (k - 4) + 2] = (mono(v.z) & ~127u) | (unsigned)(127 - (n0 + 2)); c2[4 * (k - 4) + 3] = (mono(v.w) & ~127u) | (unsigned)(127 - (n0 + 3)); } }
        bitonic_sort_desc<16>(a); bitonic_sort_desc<16>(c2);
#pragma unroll
        for (int i = 0; i < 16; ++i) a[i] = umax(a[i], c2[15 - i]);
        bitonic_merge_desc<16>(a);
        merge_partner16(a, 1, lane); merge_partner16(a, 2, lane);
        if ((lane & 3) == 0) {
#pragma unroll
            for (int i = 0; i < 4; ++i) *(LAS u32x4*)(keys1 + (lane >> 2) * 16 + 4 * i) = (u32x4){a[4 * i], a[4 * i + 1], a[4 * i + 2], a[4 * i + 3]}; }
        LDS_WAIT();
        { const int hd = lane >> 3, sl = lane & 7; unsigned x[16];
#pragma unroll
          for (int jj = 0; jj < 8; ++jj) { const unsigned code = tab[sl * 8 + jj]; const unsigned i = (code >> 4) & 15u, j = code & 15u;
              const unsigned k0 = keys1[(2 * hd) * 16 + i], k1 = keys1[(2 * hd + 1) * 16 + j];
              const float s = demono(k0 & ~127u) + demono(k1 & ~127u);
              x[jj] = code == 0xFFu ? 0u : ((mono(s) & ~255u) | (255u - code)); }
          { unsigned y[8];
#pragma unroll
            for (int i = 0; i < 8; ++i) y[i] = x[i];
            bitonic_sort_desc<8>(y);
#pragma unroll
            for (int i = 0; i < 8; ++i) x[i] = y[i];
#pragma unroll
            for (int i = 0; i < 8; ++i) x[8 + i] = shxu(y[7 - i], 1, lane); }
          bitonic_merge_desc<16>(x);
          merge_partner16(x, 2, lane); merge_partner16(x, 4, lane);
          if (sl == 0) {
#pragma unroll
              for (int i = 0; i < 4; ++i) *(LAS u32x4*)(keys2 + hd * 16 + 4 * i) = (u32x4){x[4 * i], x[4 * i + 1], x[4 * i + 2], x[4 * i + 3]}; } }
        LDS_WAIT();
        int eid0, eid1; float g0, g1;
        { const int r = lane & 15;
#pragma unroll
          for (int hs = 0; hs < 2; ++hs) { const int hd = (lane >> 4) + 4 * hs;
              const unsigned ck = keys2[hd * 16 + r]; const unsigned flat = 255u - (ck & 255u); const unsigned i = flat >> 4, j = flat & 15u;
              const unsigned k0 = keys1[(2 * hd) * 16 + i], k1 = keys1[(2 * hd + 1) * 16 + j];
              const int eid = (int)((127u - (k0 & 127u)) * 128u + (127u - (k1 & 127u)));
              const float s = demono(k0 & ~127u) + demono(k1 & ~127u);
              float mx = s; mx = fmaxf(mx, shx(mx, 1, lane)); mx = fmaxf(mx, shx(mx, 2, lane)); mx = fmaxf(mx, shx(mx, 4, lane)); mx = fmaxf(mx, shx(mx, 8, lane));
              const float e = __expf(s - mx); float sum = e; sum += shx(sum, 1, lane); sum += shx(sum, 2, lane); sum += shx(sum, 4, lane); sum += shx(sum, 8, lane);
              if (hs == 0) { eid0 = eid; g0 = e / sum; } else { eid1 = eid; g1 = e / sum; } } }
        u32x4 h0, h1;
        { const u32x4* hp = (const u32x4*)(p.H + (size_t)t * 1024) + lane; h0 = hp[0]; h1 = hp[64]; }
        float z0 = 0.f, z1 = 0.f;
        for (int bt = 0; bt < 16; ++bt) {
            const int ev = bt < 8 ? eid0 : eid1;
            u32x4 r0[8], r1[8];
#pragma unroll
            for (int e = 0; e < 8; ++e) { const int eid = __builtin_amdgcn_readlane(ev, ((bt & 7) << 3) + e);
                const u32x4* rp = (const u32x4*)(p.EU + (size_t)eid * 1024) + lane; r0[e] = rp[0]; r1[e] = rp[64]; }
            float pz[8];
#pragma unroll
            for (int e = 0; e < 8; ++e) { float d = 0.f;
#pragma unroll
                for (int i = 0; i < 4; ++i) { d = dot2bf(r0[e][i], h0[i], d); d = dot2bf(r1[e][i], h1[i], d); }
                pz[e] = d; }
            float q4[4], q2[2];
#pragma unroll
            for (int i = 0; i < 4; ++i) { const bool up = (lane & 4) != 0; const float keep = up ? pz[i + 4] : pz[i], send = up ? pz[i] : pz[i + 4]; q4[i] = keep + shx(send, 4, lane); }
#pragma unroll
            for (int i = 0; i < 2; ++i) { const bool up = (lane & 2) != 0; const float keep = up ? q4[i + 2] : q4[i], send = up ? q4[i] : q4[i + 2]; q2[i] = keep + shx(send, 2, lane); }
            float s; { const bool up = (lane & 1) != 0; const float keep = up ? q2[1] : q2[0], send = up ? q2[0] : q2[1]; s = keep + shx(send, 1, lane); }
            s += shx(s, 8, lane); s += shx(s, 16, lane); s += shx(s, 32, lane);
            const bool mine = (lane >> 3) == (bt & 7);
            if (bt < 8) z0 = mine ? s : z0; else z1 = mine ? s : z1;
        }
        const float a0 = gelu_exact(z0) * g0, a1 = gelu_exact(z1) * g1;
        float acc[16];
#pragma unroll
        for (int i = 0; i < 16; ++i) acc[i] = 0.f;
        for (int bt = 0; bt < 16; ++bt) {
            const int ev = bt < 8 ? eid0 : eid1; const float av = bt < 8 ? a0 : a1;
            u32x4 r0[8], r1[8]; float ak[8];
#pragma unroll
            for (int e = 0; e < 8; ++e) { const int sl = ((bt & 7) << 3) + e; const int eid = __builtin_amdgcn_readlane(ev, sl);
                ak[e] = __builtin_bit_cast(float, __builtin_amdgcn_readlane(__builtin_bit_cast(int, av), sl));
                const u32x4* rp = (const u32x4*)(p.EV + (size_t)eid * 1024) + lane; r0[e] = rp[0]; r1[e] = rp[64]; }
#pragma unroll
            for (int e = 0; e < 8; ++e)
#pragma unroll
                for (int i = 0; i < 4; ++i) { acc[2 * i] = __builtin_fmaf(ak[e], bf_lo(r0[e][i]), acc[2 * i]); acc[2 * i + 1] = __builtin_fmaf(ak[e], bf_hi(r0[e][i]), acc[2 * i + 1]);
                                              acc[8 + 2 * i] = __builtin_fmaf(ak[e], bf_lo(r1[e][i]), acc[8 + 2 * i]); acc[8 + 2 * i + 1] = __builtin_fmaf(ak[e], bf_hi(r1[e][i]), acc[8 + 2 * i + 1]); }
        }
        float* xr = p.X + (size_t)t * 1024 + 8 * lane; const float* gf = p.gate_f + (size_t)b * 6144 + 8 * lane;
        f32x4 xv[4]; float ss = 0.f;
#pragma unroll
        for (int i = 0; i < 4; ++i) { const int o = (i >> 1) * 512 + (i & 1) * 4; const f32x4 xo = *(const f32x4*)(xr + o), gg = *(const f32x4*)(gf + o);
            const f32x4 y = {acc[(i >> 1) * 8 + (i & 1) * 4 + 0], acc[(i >> 1) * 8 + (i & 1) * 4 + 1], acc[(i >> 1) * 8 + (i & 1) * 4 + 2], acc[(i >> 1) * 8 + (i & 1) * 4 + 3]};
            xv[i] = xo + gg * y; ss += (xv[i].x * xv[i].x + xv[i].y * xv[i].y) + (xv[i].z * xv[i].z + xv[i].w * xv[i].w); }
        const float rstd = 1.f / sqrtf(wave_sum(ss, lane) * (1.f / 1024.f) + NORM_EPS);
        if (FINAL) {
#pragma unroll
            for (int i = 0; i < 4; ++i) { const int o = (i >> 1) * 512 + (i & 1) * 4; *(f32x4*)(xr + o) = (xv[i] * rstd) * *(const f32x4*)(p.ng + 8 * lane + o); }
        } else {
            u32x4 hw[2];
#pragma unroll
            for (int i = 0; i < 4; ++i) { const int o = (i >> 1) * 512 + (i & 1) * 4; *(f32x4*)(xr + o) = xv[i];
                const f32x4 gg = *(const f32x4*)(p.ng + 8 * lane + o), sc = *(const f32x4*)(p.nsc + (size_t)b * 6144 + 8 * lane + o), sh = *(const f32x4*)(p.nsh + (size_t)b * 6144 + 8 * lane + o);
                const f32x4 y = (xv[i] * rstd) * gg * (sc + 1.0f) + sh;
                hw[i >> 1][(i & 1) * 2] = pk2(y.x, y.y); hw[i >> 1][(i & 1) * 2 + 1] = pk2(y.z, y.w); }
            u32x4* ho = (u32x4*)(p.Hout + (size_t)t * 1024) + lane; ho[0] = hw[0]; ho[64] = hw[1];
        }
    }
}

#if CHECKS
__device__ __forceinline__ void peer_naive(const Frame& F, const P& p) {
    const int lane = F.lane;
    LAS unsigned* selc = (LAS unsigned*)(F.lds + RING_OFF + F.wave * 2048);
    LAS float* selv = (LAS float*)(selc + 128);
    for (int t = F.gw; t < T; t += F.NGW) {
        const int b = t >> 12; const float* sc = p.SC + (size_t)t * 2048;
        for (int hd = 0; hd < 8; ++hd) {
            float pv = 3e38f; int pc = -1;
            for (int r = 0; r < 16; ++r) {
                float bv = -3e38f; int bc = 0x7fffffff;
                for (int m = 0; m < 256; ++m) { const int c = lane + 64 * m; const float v = sc[(2 * hd) * 128 + (c >> 7)] + sc[(2 * hd + 1) * 128 + (c & 127)];
                    const bool after = (v < pv) || (v == pv && c > pc); const bool better = (v > bv) || (v == bv && c < bc);
                    if (after && better) { bv = v; bc = c; } }
#pragma unroll
                for (int o = 1; o < 64; o <<= 1) { const float ov = shx(bv, o, lane); const int oc = (int)shxu((unsigned)bc, o, lane); if (ov > bv || (ov == bv && oc < bc)) { bv = ov; bc = oc; } }
                pv = bv; pc = bc;
                if (lane == 0) { selc[hd * 16 + r] = (unsigned)bc; selv[hd * 16 + r] = bv; }
            }
        }
        LDS_WAIT();
        float acc[16];
#pragma unroll
        for (int i = 0; i < 16; ++i) acc[i] = 0.f;
        const u32x4* hp = (const u32x4*)(p.H + (size_t)t * 1024) + lane; const u32x4 h0 = hp[0], h1 = hp[64];
        for (int hd = 0; hd < 8; ++hd) {
            float mx = -3e38f; for (int r = 0; r < 16; ++r) mx = fmaxf(mx, selv[hd * 16 + r]);
            float den = 0.f; for (int r = 0; r < 16; ++r) den += __expf(selv[hd * 16 + r] - mx);
            for (int r = 0; r < 16; ++r) {
                const int eid = (int)selc[hd * 16 + r]; const float gate = __expf(selv[hd * 16 + r] - mx) / den;
                const u32x4* up = (const u32x4*)(p.EU + (size_t)eid * 1024) + lane; const u32x4 u0 = up[0], u1 = up[64];
                float d = 0.f;
#pragma unroll
                for (int i = 0; i < 4; ++i) d += bf_lo(u0[i]) * bf_lo(h0[i]) + bf_hi(u0[i]) * bf_hi(h0[i]) + bf_lo(u1[i]) * bf_lo(h1[i]) + bf_hi(u1[i]) * bf_hi(h1[i]);
                const float z = wave_sum(d, lane); const float a = gelu_exact(z) * gate;
                const u32x4* vp = (const u32x4*)(p.EV + (size_t)eid * 1024) + lane; const u32x4 v0 = vp[0], v1 = vp[64];
#pragma unroll
                for (int i = 0; i < 4; ++i) { acc[2 * i] += a * bf_lo(v0[i]); acc[2 * i + 1] += a * bf_hi(v0[i]); acc[8 + 2 * i] += a * bf_lo(v1[i]); acc[8 + 2 * i + 1] += a * bf_hi(v1[i]); }
            }
        }
        float* xr = p.X + (size_t)t * 1024 + 8 * lane; const float* gf = p.gate_f + (size_t)b * 6144 + 8 * lane;
        f32x4 xv[4]; float ss = 0.f;
#pragma unroll
        for (int i = 0; i < 4; ++i) { const int o = (i >> 1) * 512 + (i & 1) * 4; const f32x4 xo = *(const f32x4*)(xr + o), gg = *(const f32x4*)(gf + o);
            const f32x4 y = {acc[(i >> 1) * 8 + (i & 1) * 4 + 0], acc[(i >> 1) * 8 + (i & 1) * 4 + 1], acc[(i >> 1) * 8 + (i & 1) * 4 + 2], acc[(i >> 1) * 8 + (i & 1) * 4 + 3]};
            xv[i] = xo + gg * y; ss += (xv[i].x * xv[i].x + xv[i].y * xv[i].y) + (xv[i].z * xv[i].z + xv[i].w * xv[i].w); }
        const float rstd = 1.f / sqrtf(wave_sum(ss, lane) * (1.f / 1024.f) + NORM_EPS);
#pragma unroll
        for (int i = 0; i < 4; ++i) { const int o = (i >> 1) * 512 + (i & 1) * 4; *(f32x4*)(xr + o) = (xv[i] * rstd) * *(const f32x4*)(p.ng + 8 * lane + o); }
        LDS_WAIT();
    }
}
__device__ __forceinline__ void prologue_check(const Frame& F, const Args& a, int k) {
    const unsigned s = (unsigned)(F.vcu * NTHR + F.tid);
    { const int l = (int)(s & 1u), row = (int)((s * 7919u) % 2048u), kk = (int)((s * 104729u) % 1024u); const int hp = row >> 7, n = row & 127;
      float ref = 0.f; for (int d = 0; d < 128; ++d) ref += a.peer_sub_keys[((size_t)(l * 16 + hp) * 128 + n) * 128 + d] * a.peer_w_q[(size_t)l * 1024 * 2048 + (size_t)kk * 2048 + hp * 128 + d];
      const float got = bf2f(((const bf16*)(a.ws + WS_WCOMB))[(size_t)l * 2048 * 1024 + (size_t)row * 1024 + kk]);
      if (!(fabsf(got - ref) <= 0.01f * fabsf(ref) + 1e-3f)) atomicAdd((unsigned*)(a.ws + WS_CTL) + CW_CHK + k, 1u); }
    { const size_t i = ((size_t)s * 2654435761u) % ((size_t)16384 * 1024);
      const float gu = bf2f(((const bf16*)(a.ws + WS_EU))[i]), gv = bf2f(((const bf16*)(a.ws + WS_EV))[i]); const float ru = a.peer_u[i], rv = a.peer_v[i];
      if (!(fabsf(gu - ru) <= 0.01f * fabsf(ru) + 1e-6f) || !(fabsf(gv - rv) <= 0.01f * fabsf(rv) + 1e-6f)) atomicAdd((unsigned*)(a.ws + WS_CTL) + CW_CHK + k, 1u); }
}
#endif
}

__global__ void __launch_bounds__(NTHR, 2) fwd_kernel(Args args) {
    extern __shared__ __attribute__((aligned(16))) uchar lds_raw[];
    Frame F;
    F.lds = (LAS uchar*)lds_raw;
    F.wave = __builtin_amdgcn_readfirstlane((int)threadIdx.x >> 6); F.tid = threadIdx.x; F.lane = F.tid & 63;
    F.G = gridDim.x; { const int bx = blockIdx.x; F.vcu = (F.G % 8 == 0) ? (bx % 8) * (F.G / 8) + bx / 8 : bx; }
    F.gw = F.vcu * NWAVES + F.wave; F.NGW = F.G * NWAVES;
#define F_REFRESH() do { int l_; asm volatile("v_mbcnt_lo_u32_b32 %0, -1, 0\n\tv_mbcnt_hi_u32_b32 %0, -1, %0" : "=v"(l_)); F.lane = l_; F.tid = F.wave * 64 + l_; } while (0)
    volatile LAS unsigned* MISC = (volatile LAS unsigned*)(F.lds + MISC_OFF);
    for (int u = F.tid; u < (LDS_BYTES - LDSCTL_OFF) / 4; u += NTHR) ((LAS unsigned*)(F.lds + LDSCTL_OFF))[u] = 0u;
    __syncthreads();
    XcdBarrier bar = xcd_barrier_post((unsigned*)(args.ws + WS_CTL) + CW_BAR, MISC + 8);
    const float* mod0 = (const float*)(args.ws + WS_MOD);
    const float* mod1 = mod0 + 8 * 6144;

    p0_mod(F, args);
    p0_wcomb(F, args);
    p0_weights(F, args);
    p0_rope(F, args);
    convert_tables(F, args, 0);
    xcd_barrier(bar, F.tid); F_REFRESH();
    norm_rows_adaln(F, args.x, args.norm_mix_g, mod0, 0, 1024, (bf16*)(args.ws + WS_H));
    xcd_barrier(bar, F.tid); F_REFRESH();
    bf16* const Hb = (bf16*)(args.ws + WS_H); bf16* const PROJ = (bf16*)(args.ws + WS_PROJ); bf16* const Qb = (bf16*)(args.ws + WS_Q); bf16* const KVb = (bf16*)(args.ws + WS_KV);
    {   pg8::Gemm g{Hb, (const bf16*)(args.ws + WS_WIN), T, AB_INP, 1024, 1024}; pg8::StaticOrder S; S.init(T, AB_INP, F.G, (int)blockIdx.x);
        pg8::EpiGen<0> E{PROJ, AB_INP, nullptr, nullptr, nullptr};
        pg8::gemm_phase<pg8::EpiGen<0>, pg8::StaticOrder>(F.lds + RING_OFF, g, S, E, F.tid, F.wave); }
    F_REFRESH();
    xcd_barrier(bar, F.tid); F_REFRESH();
#if CHECKS
    gemm_check(F, args, Hb, 1024, (const bf16*)(args.ws + WS_WIN), 1024, AB_INP, PROJ, AB_INP, 0, nullptr, nullptr, nullptr, 0);
    xcd_barrier(bar, F.tid); F_REFRESH();
#endif
    p3_post(F, args);
    xcd_barrier(bar, F.tid); F_REFRESH();
    {   pg8::Gemm g{PROJ + C_QLAT, (const bf16*)(args.ws + WS_WUQ), T, 768, 256, AB_INP}; pg8::StaticOrder S; S.init(T, 768, F.G, (int)blockIdx.x);
        pg8::EpiGen<0> E{Qb, 768, (const float*)(args.ws + WS_RSTDQ), nullptr, nullptr};
        pg8::gemm_phase<pg8::EpiGen<0>, pg8::StaticOrder>(F.lds + RING_OFF, g, S, E, F.tid, F.wave); }
    F_REFRESH();
    {   pg8::Gemm g{PROJ + C_KVLAT, (const bf16*)(args.ws + WS_WUKV), T, 1024, 128, AB_INP}; pg8::StaticOrder S; S.init(T, 1024, F.G, (int)blockIdx.x);
        pg8::EpiGen<0> E{KVb, 1024, (const float*)(args.ws + WS_RSTDKV), nullptr, nullptr};
        pg8::gemm_phase<pg8::EpiGen<0>, pg8::StaticOrder>(F.lds + RING_OFF, g, S, E, F.tid, F.wave); }
    F_REFRESH();
    xcd_barrier(bar, F.tid); F_REFRESH();
#if CHECKS
    gemm_check(F, args, PROJ + C_QLAT, AB_INP, (const bf16*)(args.ws + WS_WUQ), 256, 768, Qb, 768, 0, (const float*)(args.ws + WS_RSTDQ), nullptr, nullptr, 1);
    gemm_check(F, args, PROJ + C_KVLAT, AB_INP, (const bf16*)(args.ws + WS_WUKV), 128, 1024, KVb, 1024, 0, (const float*)(args.ws + WS_RSTDKV), nullptr, nullptr, 2);
    xcd_barrier(bar, F.tid); F_REFRESH();
#endif
    att::Tensors AX;
    AX.Q = Qb; AX.KV = KVb; AX.PROJ = PROJ; AX.QKV = (const bf16*)(args.ws + WS_QKV); AX.O = (bf16*)(args.ws + WS_MRG);
    AX.ropeA = (const float*)(args.ws + WS_ROPEA); AX.ropeB = (const float*)(args.ws + WS_ROPEB); AX.rel_bias = args.rel_bias; AX.hng = args.diff_head_norm_g;
    {   const int li = F.lane & 31; const float m01 = args.diff_lambda[li] * args.diff_lambda[32 + li], m23 = args.diff_lambda[64 + li] * args.diff_lambda[96 + li];
        const float d01 = wave_sum(F.lane < 32 ? m01 : 0.f, F.lane), d23 = wave_sum(F.lane < 32 ? m23 : 0.f, F.lane);
        AX.lam = expf(d01) - expf(d23) + 0.2f; }
    for (int wsel = F.vcu; wsel < 256; wsel += F.G) {
        const int bh = wsel >> 2, g = wsel & 3, b = bh >> 3, head = bh & 7;
        for (int i = 0; i < 4; ++i) { const int qt = (i == 0) ? 15 - 2 * g : (i == 1) ? 14 - 2 * g : (i == 2) ? 2 * g + 1 : 2 * g; att::attn_unit<0>(F, F.lds + RING_OFF, AX, b, head, qt); }
        for (int i = 0; i < 4; ++i) { const int qt = (i == 0) ? 15 - 2 * g : (i == 1) ? 14 - 2 * g : (i == 2) ? 2 * g + 1 : 2 * g; att::attn_unit<1>(F, F.lds + RING_OFF, AX, b, head, qt); }
    }
    xcd_barrier(bar, F.tid); F_REFRESH();
#if CHECKS
    att::attn_check<0>(F, args, AX, 3);
    att::attn_check<1>(F, args, AX, 4);
    xcd_barrier(bar, F.tid); F_REFRESH();
#endif
    bf16* const MRG = (bf16*)(args.ws + WS_MRG);
    {   pg8::Gemm g{MRG, (const bf16*)(args.ws + WS_WOAB), T, 1024, 1024, 1024}; pg8::StaticOrder S; S.init(T, 1024, F.G, (int)blockIdx.x);
        pg8::EpiGen<1> E{args.out, 1024, nullptr, args.x, mod0 + 2048};
        pg8::gemm_phase<pg8::EpiGen<1>, pg8::StaticOrder>(F.lds + RING_OFF, g, S, E, F.tid, F.wave); }
    F_REFRESH();
    xcd_barrier(bar, F.tid); F_REFRESH();
#if CHECKS
    gemm_check(F, args, MRG, 1024, (const bf16*)(args.ws + WS_WOAB), 1024, 1024, args.out, 1024, 1, nullptr, args.x, mod0 + 2048, 5);
    xcd_barrier(bar, F.tid); F_REFRESH();
#endif
    norm_rows_adaln(F, args.out, args.norm_ffn_g, mod0, 3072, 4096, Hb);
    xcd_barrier(bar, F.tid); F_REFRESH();
    float* const SCb = (float*)(args.ws + WS_SC);
    {   pg8::Gemm g{Hb, (const bf16*)(args.ws + WS_WCOMB), T, 2048, 1024, 1024}; pg8::StaticOrder S; S.init(T, 2048, F.G, (int)blockIdx.x);
        pg8::EpiGen<2> E{SCb, 2048, nullptr, nullptr, nullptr};
        pg8::gemm_phase<pg8::EpiGen<2>, pg8::StaticOrder>(F.lds + RING_OFF, g, S, E, F.tid, F.wave); }
    F_REFRESH();
    xcd_barrier(bar, F.tid); F_REFRESH();
#if CHECKS
    gemm_check(F, args, Hb, 1024, (const bf16*)(args.ws + WS_WCOMB), 1024, 2048, SCb, 2048, 2, nullptr, nullptr, nullptr, 6);
    xcd_barrier(bar, F.tid); F_REFRESH();
#endif
#if CHECKS
    peer::prologue_check(F, args, 7);
#endif
    {   peer::P pp; pp.SC = SCb; pp.H = Hb; pp.EU = (const bf16*)(args.ws + WS_EU); pp.EV = (const bf16*)(args.ws + WS_EV); pp.X = args.out; pp.gate_f = mod0 + 5120;
        pp.ng = args.norm_mix_g + 1024; pp.nsc = mod1 + 1024; pp.nsh = mod1; pp.Hout = Hb;
        peer::peer_phase<false>(F, pp); }
    xcd_barrier(bar, F.tid); F_REFRESH();
    convert_tables(F, args, 1);
    bf16* const QKVb = (bf16*)(args.ws + WS_QKV);
    {   pg8::Gemm g{Hb, (const bf16*)(args.ws + WS_WINC), T, 3072, 1024, 1024}; pg8::StaticOrder S; S.init(T, 3072, F.G, (int)blockIdx.x);
        pg8::EpiGen<0> E{QKVb, 3072, nullptr, nullptr, nullptr};
        pg8::gemm_phase<pg8::EpiGen<0>, pg8::StaticOrder>(F.lds + RING_OFF, g, S, E, F.tid, F.wave); }
    F_REFRESH();
    xcd_barrier(bar, F.tid); F_REFRESH();
    for (int wsel = F.vcu; wsel < 256; wsel += F.G) {
        const int bh = wsel >> 1, g = wsel & 1, b = bh >> 4, head = bh & 15;
        for (int i = 0; i < 8; ++i) att::attn_unit<2>(F, F.lds + RING_OFF, AX, b, head, 15 - (2 * i + g));
    }
    xcd_barrier(bar, F.tid); F_REFRESH();
#if CHECKS
    att::attn_check<2>(F, args, AX, 8);
    xcd_barrier(bar, F.tid); F_REFRESH();
#endif
    {   pg8::Gemm g{MRG, (const bf16*)(args.ws + WS_WOC), T, 1024, 1024, 1024}; pg8::StaticOrder S; S.init(T, 1024, F.G, (int)blockIdx.x);
        pg8::EpiGen<1> E{args.out, 1024, nullptr, args.out, mod1 + 2048};
        pg8::gemm_phase<pg8::EpiGen<1>, pg8::StaticOrder>(F.lds + RING_OFF, g, S, E, F.tid, F.wave); }
    F_REFRESH();
    xcd_barrier(bar, F.tid); F_REFRESH();
    norm_rows_adaln(F, args.out, args.norm_ffn_g + 1024, mod1, 3072, 4096, Hb);
    xcd_barrier(bar, F.tid); F_REFRESH();
    {   pg8::Gemm g{Hb, (const bf16*)(args.ws + WS_WCOMB) + (size_t)2048 * 1024, T, 2048, 1024, 1024}; pg8::StaticOrder S; S.init(T, 2048, F.G, (int)blockIdx.x);
        pg8::EpiGen<2> E{SCb, 2048, nullptr, nullptr, nullptr};
        pg8::gemm_phase<pg8::EpiGen<2>, pg8::StaticOrder>(F.lds + RING_OFF, g, S, E, F.tid, F.wave); }
    F_REFRESH();
    xcd_barrier(bar, F.tid); F_REFRESH();
    {   peer::P pp; pp.SC = SCb; pp.H = Hb; pp.EU = (const bf16*)(args.ws + WS_EU); pp.EV = (const bf16*)(args.ws + WS_EV); pp.X = args.out; pp.gate_f = mod1 + 5120;
        pp.ng = args.final_norm_g; pp.nsc = nullptr; pp.nsh = nullptr; pp.Hout = nullptr;
        peer::peer_phase<true>(F, pp); }
#if CHECKS
    {
        const unsigned* ctl = (const unsigned*)(args.ws + WS_CTL);
        unsigned code = 0; for (int k = 0; k < 9; ++k) if (__hip_atomic_load(ctl + CW_CHK + k, __ATOMIC_RELAXED, __HIP_MEMORY_SCOPE_AGENT)) code |= 1u << k;
        if (__hip_atomic_load(ctl + CW_BAR + XB_TMO, __ATOMIC_RELAXED, __HIP_MEMORY_SCOPE_AGENT)) code |= 1u << 9;
        if (code) { xcd_barrier(bar, F.tid); const float scl = 1.f + (float)code;
            for (size_t i = (size_t)F.vcu * NTHR + F.tid; i < (size_t)T * D; i += (size_t)F.G * NTHR) args.out[i] *= scl; }
    }
#endif
}

extern "C" void kernel_launch(void* const* d_in, const int* in_sizes, int n_in, void* d_out, int out_size, void* d_ws, size_t ws_size, hipStream_t stream) {
    static int grid = 0;
    if (grid == 0) {
        if (n_in != 23 || out_size != T * D || ws_size < WS_END) { fprintf(stderr, "kernel_launch: unexpected shapes (n_in %d out %d ws %zu)\n", n_in, out_size, ws_size); grid = -1; return; }
        int dev = 0, cus = 0, per_cu = 0;
        if (hipGetDevice(&dev) != hipSuccess || hipDeviceGetAttribute(&cus, hipDeviceAttributeMultiprocessorCount, dev) != hipSuccess) { grid = -1; return; }
        if (hipFuncSetAttribute((const void*)fwd_kernel, hipFuncAttributeMaxDynamicSharedMemorySize, LDS_BYTES) != hipSuccess) { fprintf(stderr, "kernel_launch: hipFuncSetAttribute failed\n"); grid = -1; return; }
        if (hipOccupancyMaxActiveBlocksPerMultiprocessor(&per_cu, (const void*)fwd_kernel, NTHR, LDS_BYTES) != hipSuccess || per_cu < 1)
            fprintf(stderr, "kernel_launch: occupancy query reports %d per CU\n", per_cu);
        (void)hipGetLastError();
        grid = cus;
    }
    if (grid < 0) return;
    if (hipMemsetAsync((char*)d_ws + WS_CTL, 0, CTL_ZERO_BYTES, stream) != hipSuccess) return;
    Args a{};
    a.x = (const float*)d_in[0]; a.c = (const float*)d_in[1]; a.pos = (const int*)d_in[2]; a.ada_w = (const float*)d_in[3]; a.ada_b = (const float*)d_in[4];
    a.norm_mix_g = (const float*)d_in[5]; a.norm_ffn_g = (const float*)d_in[6]; a.w_in_ab = (const float*)d_in[7]; a.mla_q_norm_g = (const float*)d_in[8];
    a.mla_w_uq = (const float*)d_in[9]; a.mla_kv_norm_g = (const float*)d_in[10]; a.mla_w_ukv = (const float*)d_in[11]; a.diff_lambda = (const float*)d_in[12];
    a.diff_head_norm_g = (const float*)d_in[13]; a.w_out_ab = (const float*)d_in[14]; a.w_in_c = (const float*)d_in[15]; a.rel_bias = (const float*)d_in[16];
    a.w_out_c = (const float*)d_in[17]; a.peer_w_q = (const float*)d_in[18]; a.peer_sub_keys = (const float*)d_in[19]; a.peer_u = (const float*)d_in[20];
    a.peer_v = (const float*)d_in[21]; a.final_norm_g = (const float*)d_in[22];
    a.out = (float*)d_out; a.ws = (uchar*)d_ws;
    for (int i = 0; i < 16; ++i) a.inv_freq_a[i] = (float)pow(500000.0, -(double)(2 * i) / 32.0);
    for (int i = 0; i < 4; ++i) a.inv_freq_b[i] = (float)pow(500000.0, -(double)(2 * i) / 8.0);
    hipLaunchKernelGGL(fwd_kernel, dim3(grid), dim3(NTHR), LDS_BYTES, stream, a);
}
```

```cpp
#include <hip/hip_runtime.h>
#include <cstdio>
#include <cstdint>
#include <cmath>

#ifndef REP_PEER
#define REP_PEER 1
#endif
#ifndef REP_ATT
#define REP_ATT 1
#endif
#ifndef REP_GEMM
#define REP_GEMM 1
#endif

#define GAS __attribute__((address_space(1)))
#define LAS __attribute__((address_space(3)))
typedef unsigned short bf16;
typedef unsigned char uchar;
typedef short bf16x8 __attribute__((ext_vector_type(8)));
typedef short s16x4 __attribute__((ext_vector_type(4)));
typedef float f32x4 __attribute__((ext_vector_type(4)));
typedef float f32x2 __attribute__((ext_vector_type(2)));
typedef float f32x16 __attribute__((ext_vector_type(16)));
typedef unsigned u32x4 __attribute__((ext_vector_type(4)));
typedef unsigned u32x2 __attribute__((ext_vector_type(2)));
typedef __bf16 bf2v __attribute__((ext_vector_type(2)));

constexpr int NB = 8, SEQ = 4096, D = 1024, T = NB * SEQ;
constexpr int AB_IN = 1952, AB_INP = 2048;
constexpr int NWAVES = 8, NTHR = 512;
constexpr float NORM_EPS = 1e-6f;
constexpr int C_QLAT = 0, C_KVLAT = 256, C_KPE = 384, C_BQ = 416, C_BK = 928, C_BV = 1440;

constexpr size_t MiB = 1u << 20;
constexpr size_t WS_CTL = 0, CTL_ZERO_BYTES = 1 * MiB;
constexpr size_t WS_MOD = 1 * MiB;
constexpr size_t WS_RSTDQ = WS_MOD + 512 * 1024;
constexpr size_t WS_RSTDKV = WS_RSTDQ + 128 * 1024;
constexpr size_t WS_ROPEA = 2 * MiB;
constexpr size_t WS_ROPEB = 6 * MiB;
constexpr size_t WS_WIN = 8 * MiB;
constexpr size_t WS_WUQ = 12 * MiB;
constexpr size_t WS_WUKV = 12 * MiB + 512 * 1024;
constexpr size_t WS_WOAB = 13 * MiB;
constexpr size_t WS_WINC = 15 * MiB;
constexpr size_t WS_WOC = 21 * MiB;
constexpr size_t WS_WCOMB = 23 * MiB;
constexpr size_t WS_EU = 32 * MiB;
constexpr size_t WS_EV = 64 * MiB;
constexpr size_t WS_H = 96 * MiB;
constexpr size_t WS_MRG = 160 * MiB;
constexpr size_t WS_R = 224 * MiB;
constexpr size_t WS_PROJ = WS_R;
constexpr size_t WS_Q = WS_R + 128 * MiB;
constexpr size_t WS_KV = WS_R + 176 * MiB;
constexpr size_t WS_QKV = WS_R;
constexpr size_t WS_SC = WS_R;
constexpr size_t WS_TU = 32 * MiB;
constexpr size_t WS_TV = 64 * MiB;
constexpr size_t WS_SCL = WS_MOD + 768 * 1024;
constexpr size_t WS_HS = 31 * MiB;
constexpr size_t WS_IDX = WS_MRG;
constexpr size_t WS_GATE = WS_MRG + 8 * MiB;
constexpr size_t WS_ZP = WS_R;
constexpr size_t WS_AK = WS_R + 128 * MiB;
constexpr size_t WS_END = 480 * MiB;

constexpr int CW_BAR = 4096;

constexpr int RING_OFF = 0, RING_BYTES = 131072;
constexpr int LDSCTL_OFF = RING_BYTES, MISC_OFF = LDSCTL_OFF + 320;
constexpr int LDS_BYTES = 147456;

#define LDS_WAIT() asm volatile("s_waitcnt lgkmcnt(0)" ::: "memory")
#define VM_WAIT() asm volatile("s_waitcnt vmcnt(0)" ::: "memory")

__device__ __forceinline__ unsigned pk2(float lo, float hi) { f32x2 v = {lo, hi}; bf2v b = __builtin_convertvector(v, bf2v); return __builtin_bit_cast(unsigned, b); }
__device__ __forceinline__ float bf_lo(unsigned w) { return __builtin_bit_cast(float, w << 16); }
__device__ __forceinline__ float bf_hi(unsigned w) { return __builtin_bit_cast(float, w & 0xffff0000u); }

#define XB_TMO      128
#define XB_XCNT(j)  (256  + 64 * (j))
#define XB_XSUB(j)  (1280 + 64 * (j))
#define XB_XGEN(j)  (2304 + 64 * (j))
#define XB_TOP      3328
#define XB_TOPGEN   3392
#define XCD_BAR_WORDS 3456
#define XB_SPIN_CAP (1u << 18)

__device__ __forceinline__ unsigned xb_ld(unsigned* p)              { return __hip_atomic_load(p, __ATOMIC_RELAXED, __HIP_MEMORY_SCOPE_AGENT); }
__device__ __forceinline__ unsigned xb_add(unsigned* p, unsigned v) { return __hip_atomic_fetch_add(p, v, __ATOMIC_RELAXED, __HIP_MEMORY_SCOPE_AGENT); }
__device__ __forceinline__ unsigned xb_xcc_id() { return (unsigned)__builtin_amdgcn_s_getreg((3 << 11) | 20) & 0xFu; }
#define XB_SPIN(cond, bar) do { unsigned _sp = 0; while (cond) { __builtin_amdgcn_s_sleep(1); \
    if ((++_sp & 255u) == 0u) { if (xb_ld(&(bar)[XB_TMO])) break; if (_sp > XB_SPIN_CAP) { atomicAdd(&(bar)[XB_TMO], 1u); break; } } } } while (0)

struct XcdBarrier { unsigned* bar; unsigned x; volatile LAS unsigned* st; };

__device__ __forceinline__ XcdBarrier xcd_barrier_post(unsigned* bar, volatile LAS unsigned* st) {
    XcdBarrier b; b.bar = bar; b.x = xb_xcc_id(); b.st = st;
    if (threadIdx.x == 0) (void)xb_add(&bar[XB_XCNT(b.x)], 1u);
    return b;
}
__device__ __forceinline__ void xcd_barrier_complete(unsigned* bar, unsigned x, unsigned& nloc, unsigned& nx) {
    const unsigned G = gridDim.x * gridDim.y * gridDim.z;
    unsigned sum, cnt, mine, sp = 0u;
    for (;;) {
        sum = 0u; cnt = 0u; mine = 0u;
#pragma unroll
        for (unsigned j = 0; j < 16; ++j) { const unsigned c = xb_ld(&bar[XB_XCNT(j)]); sum += c; cnt += (c > 0u) ? 1u : 0u; mine = (j == x) ? c : mine; }
        if (sum == G) break;
        __builtin_amdgcn_s_sleep(1);
        if ((++sp & 255u) == 0u) { if (xb_ld(&bar[XB_TMO])) break; if (sp > XB_SPIN_CAP) { atomicAdd(&bar[XB_TMO], 1u); break; } }
    }
    nloc = mine > 0u ? mine : 1u; nx = cnt > 0u ? cnt : 1u;
}
__device__ __forceinline__ void xcd_barrier(const XcdBarrier& b, int tid_) {
    asm volatile("s_waitcnt vmcnt(0)" ::: "memory");
    __syncthreads();
    if (tid_ == 0) {
        unsigned* bar = b.bar;
        __builtin_amdgcn_s_waitcnt(0);
        unsigned nloc = b.st[0], nx = b.st[1];
        if (nloc == 0u) { xcd_barrier_complete(bar, b.x, nloc, nx); b.st[0] = nloc; b.st[1] = nx; }
        const unsigned old = xb_add(&bar[XB_XSUB(b.x)], 1u);
        const unsigned gen = old / nloc;
        if (old + 1u == (gen + 1u) * nloc) {
            __builtin_amdgcn_fence(__ATOMIC_RELEASE, "agent");
            asm volatile("s_waitcnt vmcnt(0)" ::: "memory");
            const unsigned og = xb_add(&bar[XB_TOP], 1u);
            const unsigned tg = og / nx;
            if (og + 1u == (tg + 1u) * nx) xb_add(&bar[XB_TOPGEN], 1u);
            else XB_SPIN(xb_ld(&bar[XB_TOPGEN]) == tg, bar);
            __builtin_amdgcn_fence(__ATOMIC_ACQUIRE, "agent");
            xb_add(&bar[XB_XGEN(b.x)], 1u);
            asm volatile("s_waitcnt vmcnt(0)" ::: "memory");
        } else {
            XB_SPIN(xb_ld(&bar[XB_XGEN(b.x)]) == gen, bar);
            __builtin_amdgcn_fence(__ATOMIC_ACQUIRE, "agent");
            asm volatile("s_waitcnt vmcnt(0)" ::: "memory");
        }
    }
    __syncthreads();
}

struct Args {
    const float* x; const float* c; const int* pos; const float* ada_w; const float* ada_b; const float* norm_mix_g; const float* norm_ffn_g;
    const float* w_in_ab; const float* mla_q_norm_g; const float* mla_w_uq; const float* mla_kv_norm_g; const float* mla_w_ukv; const float* diff_lambda;
    const float* diff_head_norm_g; const float* w_out_ab; const float* w_in_c; const float* rel_bias; const float* w_out_c; const float* peer_w_q;
    const float* peer_sub_keys; const float* peer_u; const float* peer_v; const float* final_norm_g;
    float* out; uchar* ws;
    float inv_freq_a[16]; float inv_freq_b[4];
};

struct Frame {
    LAS uchar* lds;
    int tid, lane, wave, vcu, G, gw, NGW;
};

__device__ __forceinline__ float shx(float v, int mask, int lane) { return __builtin_bit_cast(float, __builtin_amdgcn_ds_bpermute((lane ^ mask) << 2, __builtin_bit_cast(int, v))); }
__device__ __forceinline__ float wave_sum(float v, int lane) {
#pragma unroll
    for (int o = 1; o < 64; o <<= 1) v += shx(v, o, lane);
    return v;
}

__device__ __forceinline__ void transpose_item(const float* W, int K, int N, bf16* WT, const float* kscale, LAS float* scr, int item, int lane) {
    const int nblk = N / 32, kb = item / nblk, nb = item % nblk, k0 = 64 * kb, n0 = 32 * nb;
#pragma unroll 8
    for (int i = 0; i < 32; ++i) { const int kk = 2 * i + (lane >> 5); float v = W[(size_t)(k0 + kk) * N + n0 + (lane & 31)]; if (kscale) v *= kscale[k0 + kk]; scr[kk * 33 + (lane & 31)] = v; }
    LDS_WAIT(); asm volatile("" ::: "memory");
    const int c = lane & 7;
#pragma unroll
    for (int j = 0; j < 4; ++j) { const int n = (lane >> 3) + 8 * j; const LAS float* s = scr + (8 * c) * 33 + n;
        u32x4 o; o.x = pk2(s[0 * 33], s[1 * 33]); o.y = pk2(s[2 * 33], s[3 * 33]); o.z = pk2(s[4 * 33], s[5 * 33]); o.w = pk2(s[6 * 33], s[7 * 33]);
        *(u32x4*)(WT + (size_t)(n0 + n) * K + k0 + 8 * c) = o; }
    LDS_WAIT(); asm volatile("" ::: "memory");
}

__device__ __forceinline__ void convert_tables(const Frame& F, const Args& a, int l) {
    const size_t n8 = (size_t)16384 * 1024 / 8;
    const f32x4* su = (const f32x4*)(a.peer_u + (size_t)l * 16384 * 1024);
    const f32x4* sv = (const f32x4*)(a.peer_v + (size_t)l * 16384 * 1024);
    u32x4* du = (u32x4*)(a.ws + WS_EU); u32x4* dv = (u32x4*)(a.ws + WS_EV);
    const size_t gt = (size_t)F.vcu * NTHR + F.tid, NT = (size_t)F.G * NTHR;
    for (size_t i = gt; i < n8; i += NT) {
        const f32x4 p0 = su[2 * i], p1 = su[2 * i + 1], q0 = sv[2 * i], q1 = sv[2 * i + 1];
        u32x4 o; o.x = pk2(p0.x, p0.y); o.y = pk2(p0.z, p0.w); o.z = pk2(p1.x, p1.y); o.w = pk2(p1.z, p1.w); du[i] = o;
        u32x4 r; r.x = pk2(q0.x, q0.y); r.y = pk2(q0.z, q0.w); r.z = pk2(q1.x, q1.y); r.w = pk2(q1.z, q1.w); dv[i] = r;
    }
}

__device__ __forceinline__ float silu_f(float v) { return v / (1.f + __expf(-v)); }

__device__ __forceinline__ void p0_mod(const Frame& F, const Args& a) {
    LAS float* cond = (LAS float*)(F.lds + RING_OFF);
    LAS float* red = (LAS float*)(F.lds + RING_OFF + 32768);
    bool have = false;
    for (int it = F.vcu; it < 192; it += F.G) {
        if (!have) { for (int i = F.tid; i < 8192; i += NTHR) cond[i] = silu_f(a.c[i]); __syncthreads(); have = true; }
        const int l = it / 96, j0 = (it % 96) * 64;
        const float* W = a.ada_w + (size_t)l * 1024 * 6144 + j0 + F.lane;
        float acc[8];
#pragma unroll
        for (int b = 0; b < 8; ++b) acc[b] = 0.f;
        const int kbeg = F.wave * 128;
#pragma unroll 8
        for (int k = kbeg; k < kbeg + 128; ++k) { const float w = W[(size_t)k * 6144];
#pragma unroll
            for (int b = 0; b < 8; ++b) acc[b] += cond[b * 1024 + k] * w; }
#pragma unroll
        for (int b = 0; b < 8; ++b) red[(F.wave * 8 + b) * 64 + F.lane] = acc[b];
        __syncthreads();
        { const int b = F.tid >> 6; float s = a.ada_b[l * 6144 + j0 + F.lane];
#pragma unroll
          for (int w = 0; w < 8; ++w) s += red[(w * 8 + b) * 64 + F.lane];
          ((float*)(a.ws + WS_MOD))[(size_t)(l * 8 + b) * 6144 + j0 + F.lane] = s; }
        __syncthreads();
    }
    __syncthreads();
}

__device__ __forceinline__ void p0_rope(const Frame& F, const Args& a) {
    const int gt = F.vcu * NTHR + F.tid, NT = F.G * NTHR;
    float* ra = (float*)(a.ws + WS_ROPEA); float* rb = (float*)(a.ws + WS_ROPEB);
    for (int i = gt; i < T * 20; i += NT) {
        const int t = i / 20, f = i % 20;
        const float invf = f < 16 ? a.inv_freq_a[f] : a.inv_freq_b[f - 16];
        const float ang = (float)a.pos[t] * invf;
        const double ad = (double)ang; const double kq = rint(ad * 0.15915494309189535); const float r = (float)(ad - kq * 6.283185307179586);
        const float cs = cosf(r), sn = sinf(r);
        if (f < 16) { ra[t * 32 + f] = cs; ra[t * 32 + 16 + f] = sn; } else { rb[t * 8 + (f - 16)] = cs; rb[t * 8 + 4 + (f - 16)] = sn; }
    }
}

__device__ __forceinline__ void p0_wcomb(const Frame& F, const Args& a) {
    LAS float* skT = (LAS float*)(F.lds + RING_OFF);
    LAS float* wqT = (LAS float*)(F.lds + RING_OFF + 128 * 132 * 4);
    for (int it = F.vcu; it < 512; it += F.G) {
        const int l = it >> 8, hp = (it >> 4) & 15, kb = it & 15;
        const float* sk = a.peer_sub_keys + ((size_t)(l * 16 + hp) * 128) * 128;
        const float* wq = a.peer_w_q + (size_t)l * 1024 * 2048 + (size_t)(kb * 64) * 2048 + hp * 128;
        for (int i = F.tid; i < 128 * 128; i += NTHR) { const int n = i >> 7, d = i & 127; skT[d * 132 + n] = sk[i]; }
        for (int i = F.tid; i < 64 * 128; i += NTHR) { const int k = i >> 7, d = i & 127; wqT[d * 68 + k] = wq[(size_t)k * 2048 + d]; }
        __syncthreads();
        const int tn = F.tid & 31, tk = F.tid >> 5;
        f32x4 acc[4];
#pragma unroll
        for (int i = 0; i < 4; ++i) acc[i] = (f32x4){0.f, 0.f, 0.f, 0.f};
#pragma unroll 4
        for (int d = 0; d < 128; ++d) {
            const f32x4 av = *(const LAS f32x4*)(skT + d * 132 + 4 * tn), bv = *(const LAS f32x4*)(wqT + d * 68 + 4 * tk);
            acc[0] += av.x * bv; acc[1] += av.y * bv; acc[2] += av.z * bv; acc[3] += av.w * bv;
        }
        bf16* WT = (bf16*)(a.ws + WS_WCOMB) + (size_t)l * 2048 * 1024;
#pragma unroll
        for (int i = 0; i < 4; ++i) { u32x2 o; o.x = pk2(acc[i].x, acc[i].y); o.y = pk2(acc[i].z, acc[i].w);
            *(u32x2*)(WT + (size_t)(hp * 128 + 4 * tn + i) * 1024 + kb * 64 + 4 * tk) = o; }
        __syncthreads();
    }
}

__device__ __forceinline__ void p0_weights(const Frame& F, const Args& a) {
    LAS float* scr = (LAS float*)(F.lds + RING_OFF + F.wave * 16384);
    bf16* WinT = (bf16*)(a.ws + WS_WIN); bf16* WuqT = (bf16*)(a.ws + WS_WUQ); bf16* WukvT = (bf16*)(a.ws + WS_WUKV);
    bf16* WoabT = (bf16*)(a.ws + WS_WOAB); bf16* WincT = (bf16*)(a.ws + WS_WINC); bf16* WocT = (bf16*)(a.ws + WS_WOC);
    constexpr int I_IN = 16 * 61, I_UQ = 4 * 24, I_UKV = 2 * 32, I_OAB = 16 * 32, I_INC = 16 * 96, I_OC = 16 * 32;
    constexpr int NITEMS = I_IN + I_UQ + I_UKV + I_OAB + I_INC + I_OC;
    for (int it = F.gw; it < NITEMS; it += F.NGW) {
        int r = it;
        if (r < I_IN) { transpose_item(a.w_in_ab, 1024, AB_IN, WinT, nullptr, scr, r, F.lane); continue; } r -= I_IN;
        if (r < I_UQ) { transpose_item(a.mla_w_uq, 256, 768, WuqT, a.mla_q_norm_g, scr, r, F.lane); continue; } r -= I_UQ;
        if (r < I_UKV) { transpose_item(a.mla_w_ukv, 128, 1024, WukvT, a.mla_kv_norm_g, scr, r, F.lane); continue; } r -= I_UKV;
        if (r < I_OAB) { transpose_item(a.w_out_ab, 1024, 1024, WoabT, nullptr, scr, r, F.lane); continue; } r -= I_OAB;
        if (r < I_INC) { transpose_item(a.w_in_c, 1024, 3072, WincT, nullptr, scr, r, F.lane); continue; } r -= I_INC;
        transpose_item(a.w_out_c, 1024, 1024, WocT, nullptr, scr, r, F.lane);
    }
    { u32x4* z = (u32x4*)(WinT + (size_t)AB_IN * 1024); const int n16 = (AB_INP - AB_IN) * 1024 * 2 / 16;
      for (int i = F.vcu * NTHR + F.tid; i < n16; i += F.G * NTHR) z[i] = (u32x4){0u, 0u, 0u, 0u}; }
}

__device__ __forceinline__ void norm_rows_adaln(const Frame& F, const float* src, const float* g, const float* modl, int sh_off, int sc_off, bf16* dst) {
    for (int row = F.gw; row < T; row += F.NGW) {
        const int b = row >> 12;
        const f32x4* xr = (const f32x4*)(src + (size_t)row * D) + F.lane;
        f32x4 v[4]; float s = 0.f;
#pragma unroll
        for (int j = 0; j < 4; ++j) { v[j] = xr[64 * j]; s += (v[j].x * v[j].x + v[j].y * v[j].y) + (v[j].z * v[j].z + v[j].w * v[j].w); }
        const float rstd = 1.f / sqrtf(wave_sum(s, F.lane) * (1.f / D) + NORM_EPS);
        const f32x4* gp = (const f32x4*)g + F.lane; const f32x4* scp = (const f32x4*)(modl + (size_t)b * 6144 + sc_off) + F.lane; const f32x4* shp = (const f32x4*)(modl + (size_t)b * 6144 + sh_off) + F.lane;
        u32x2* o8 = (u32x2*)(dst + (size_t)row * D) + F.lane;
#pragma unroll
        for (int j = 0; j < 4; ++j) { const f32x4 gg = gp[64 * j], sc = scp[64 * j], sh = shp[64 * j];
            const f32x4 y = (v[j] * rstd) * gg * (sc + 1.0f) + sh;
            u32x2 o; o.x = pk2(y.x, y.y); o.y = pk2(y.z, y.w); o8[64 * j] = o; }
    }
}
__device__ __forceinline__ void norm_rows_final(const Frame& F, const float* src, const float* g, float* dst) {
    for (int row = F.gw; row < T; row += F.NGW) {
        const f32x4* xr = (const f32x4*)(src + (size_t)row * D) + F.lane;
        f32x4 v[4]; float s = 0.f;
#pragma unroll
        for (int j = 0; j < 4; ++j) { v[j] = xr[64 * j]; s += (v[j].x * v[j].x + v[j].y * v[j].y) + (v[j].z * v[j].z + v[j].w * v[j].w); }
        const float rstd = 1.f / sqrtf(wave_sum(s, F.lane) * (1.f / D) + NORM_EPS);
        const f32x4* gp = (const f32x4*)g + F.lane; f32x4* o = (f32x4*)(dst + (size_t)row * D) + F.lane;
#pragma unroll
        for (int j = 0; j < 4; ++j) o[64 * j] = (v[j] * rstd) * gp[64 * j];
    }
}


namespace pg8 {
constexpr int BM = 256, BK = 64, HALF = 128, HTB = HALF * BK * 2, STAGE_BYTES = 8 * HTB, NXCD = 8, WGM = 8;
__host__ __device__ __forceinline__ int lds_byte(int r, int c) { const int st = (r >> 4) * 2 + (c >> 5), rr = r & 15, cc = c & 31, ob = rr * 64 + cc * 2; return st * 1024 + (ob ^ (((ob >> 9) & 1) << 5)); }
__host__ __device__ __forceinline__ void stage_rc(int b, int& R, int& C) { const int st = b / 1024, sb = b % 1024, swz = sb ^ (((sb >> 9) & 1) << 5); R = (st >> 1) * 16 + swz / 64; C = (st & 1) * 32 + (swz % 64) / 2; }
__host__ __device__ __forceinline__ int perm32(int rho) { const int n = rho >> 4, i = rho & 15; return 8 * (i >> 2) + 4 * n + (i & 3); }

struct Unit { int pm, pn; };
struct Gemm { const bf16* A; const bf16* Bt; int M, N, K, lda; };

struct StaticOrder {
    int nM, nN, nwg, G, c;
    __host__ __device__ void init(int M, int N, int G_, int c_) { nM = M / BM; nN = N / BM; nwg = nM * nN; G = G_; c = c_; }
    __host__ __device__ bool next(int i, Unit& u) const {
        const long L = (long)i * G + c; if (L >= nwg) return false;
        int wgid = (int)L; { const int q = nwg / NXCD, r = nwg % NXCD, xcd = wgid % NXCD, off = wgid / NXCD; wgid = (xcd < r ? xcd * (q + 1) : r * (q + 1) + (xcd - r) * q) + off; }
        const int nig = WGM * nN, gid = wgid / nig, fm = gid * WGM, gsz = (nM - fm) < WGM ? (nM - fm) : WGM;
        u.pm = fm + ((wgid % nig) % gsz); u.pn = (wgid % nig) / gsz; return true;
    }
    __device__ __forceinline__ void a_ready(const Unit&) const {}
    __device__ __forceinline__ void done(const Unit&) const {}
};

template <int MODE> struct EpiGen {
    static constexpr bool PERM = true, AFTER_DRAIN = false;
    void* O; int ldc; const float* rscale; const float* base; const float* gate;
    __device__ __forceinline__ void operator()(const f32x4 (&acc)[2][2][4][2], const Unit& u, int wr, int wc, int fr, int fq) const {
        const int row0 = u.pm * BM + wr * 64 + fr, col0 = u.pn * BM + wc * 32 + 8 * fq;
#pragma unroll
        for (int ai = 0; ai < 2; ++ai)
#pragma unroll
            for (int m = 0; m < 4; ++m) {
                const int row = row0 + ai * HALF + m * 16;
                float sc = 1.f; if (MODE == 0 && rscale) sc = rscale[row];
#pragma unroll
                for (int bj = 0; bj < 2; ++bj) {
                    const int col = col0 + bj * HALF;
                    f32x4 v0 = acc[ai][bj][m][0], v1 = acc[ai][bj][m][1];
                    if (MODE == 0) {
                        v0 = v0 * sc; v1 = v1 * sc;
                        u32x4 w; w.x = pk2(v0[0], v0[1]); w.y = pk2(v0[2], v0[3]); w.z = pk2(v1[0], v1[1]); w.w = pk2(v1[2], v1[3]);
                        *(u32x4*)((bf16*)O + (size_t)row * ldc + col) = w;
                    } else if (MODE == 1) {
                        const float* gp = gate + (size_t)(row >> 12) * 6144 + col; const float* bp = base + (size_t)row * ldc + col; float* op = (float*)O + (size_t)row * ldc + col;
                        const f32x4 g0 = *(const f32x4*)gp, g1 = *(const f32x4*)(gp + 4), b0 = *(const f32x4*)bp, b1 = *(const f32x4*)(bp + 4);
                        *(f32x4*)op = b0 + g0 * v0; *(f32x4*)(op + 4) = b1 + g1 * v1;
                    } else {
                        float* op = (float*)O + (size_t)row * ldc + col;
                        *(f32x4*)op = v0; *(f32x4*)(op + 4) = v1;
                    }
                }
            }
    }
};

template <class Epi, class Sched, bool ALIGN_EPI = true>
__device__ __forceinline__ void gemm_phase(LAS uchar* lds, const Gemm g, const Sched& S, const Epi& E, int tid, int wid) {
    const int lane = tid & 63, wr = wid >> 2, wc = wid & 3, fr = lane & 15, fq = lane >> 4;
    const int K = g.K, nt = K / BK, lda = g.lda;
    unsigned voffA[2], voffB[2];
#pragma unroll
    for (int i = 0; i < 2; ++i) { int R, C; stage_rc(tid * 16 + i * 8192, R, C); const int Rb = Epi::PERM ? ((R & ~31) + perm32(R & 31)) : R;
        voffA[i] = (unsigned)(R * lda + C) * 2u; voffB[i] = (unsigned)(Rb * K + C) * 2u; }
    const size_t kstep = (size_t)(BK * 2);
    const size_t hstepA = (size_t)HALF * lda * 2, hstepB = (size_t)HALF * K * 2;
    const size_t tstepA = 2 * hstepA, tstepB = 2 * hstepB;
    const unsigned ldsw = (unsigned)wid * 1024u;
    const int aoff = lds_byte(wr * 64 + fr, fq * 8), boff = lds_byte(wc * 32 + fr, fq * 8);
#define PG8_SA(b, h) (((b) * 2 + (h)) * HTB)
#define PG8_SB(b, h) ((4 + (b) * 2 + (h)) * HTB)
#define PG8_STAGE(bufoff, gbase, voff) do { _Pragma("unroll") for (int _i = 0; _i < 2; ++_i) \
        __builtin_amdgcn_global_load_lds((const unsigned*)((const char*)(gbase) + (voff)[_i]), (LAS unsigned*)(lds + (bufoff) + ldsw + _i * 8192), 16, 0, 0); } while (0)
#define PG8_LDA(dst, b, h) do { _Pragma("unroll") for (int m = 0; m < 4; ++m) _Pragma("unroll") for (int k = 0; k < 2; ++k) dst[m][k] = *(const LAS bf16x8*)(lds + PG8_SA(b, h) + aoff + m * 2048 + k * 1024); } while (0)
#define PG8_LDB(dst, b, h) do { _Pragma("unroll") for (int n = 0; n < 2; ++n) _Pragma("unroll") for (int k = 0; k < 2; ++k) dst[n][k] = *(const LAS bf16x8*)(lds + PG8_SB(b, h) + boff + n * 2048 + k * 1024); } while (0)
#define PG8_MMA(ai, bj, At, Bt) do { __builtin_amdgcn_s_setprio(1); _Pragma("unroll") for (int m = 0; m < 4; ++m) _Pragma("unroll") for (int n = 0; n < 2; ++n) _Pragma("unroll") for (int k = 0; k < 2; ++k) \
        acc[ai][bj][m][n] = __builtin_amdgcn_mfma_f32_16x16x32_bf16(Bt[n][k], At[m][k], acc[ai][bj][m][n], 0, 0, 0); __builtin_amdgcn_s_setprio(0); } while (0)
#define PG8_WAIT_V(n) asm volatile("s_waitcnt vmcnt(" #n ")" ::: "memory")
#define PG8_WAIT_L(n) asm volatile("s_waitcnt lgkmcnt(" #n ")" ::: "memory")
#define PG8_BAR __builtin_amdgcn_s_barrier()
#define PG8_SCHED __builtin_amdgcn_sched_barrier(0)
    Unit cur, nxt; int ui = 0;
    if (!S.next(0, cur)) return;
    f32x4 acc[2][2][4][2];
#pragma unroll
    for (int a = 0; a < 2; ++a)
#pragma unroll
        for (int b = 0; b < 2; ++b)
#pragma unroll
            for (int m = 0; m < 4; ++m)
#pragma unroll
                for (int n = 0; n < 2; ++n) acc[a][b][m][n] = (f32x4){0.f, 0.f, 0.f, 0.f};
    bf16x8 At[4][2], B0[2][2], B1[2][2];
    const char* cA = (const char*)g.A + (size_t)cur.pm * tstepA; const char* cB = (const char*)g.Bt + (size_t)cur.pn * tstepB;
    S.a_ready(cur);
    PG8_STAGE(PG8_SB(0, 0), cB, voffB); PG8_STAGE(PG8_SB(0, 1), cB + hstepB, voffB); PG8_STAGE(PG8_SA(0, 0), cA, voffA); PG8_STAGE(PG8_SA(0, 1), cA + hstepA, voffA);
    if (wr == 1) PG8_BAR;
    PG8_WAIT_V(2); PG8_BAR;
    PG8_STAGE(PG8_SB(1, 0), cB + kstep, voffB); PG8_STAGE(PG8_SA(1, 0), cA + kstep, voffA); PG8_STAGE(PG8_SB(1, 1), cB + hstepB + kstep, voffB);
    PG8_WAIT_V(6); PG8_BAR;
    for (;;) {
        const bool has_next = S.next(ui + 1, nxt);
        const char* nA = has_next ? (const char*)g.A + (size_t)nxt.pm * tstepA : cA; const char* nB = has_next ? (const char*)g.Bt + (size_t)nxt.pn * tstepB : cB;
        for (int t = 0; t < nt; t += 2) {
            const bool last = (t == nt - 2);
            const char* a1 = cA + (size_t)(t + 1) * kstep;
            const char* a2 = last ? nA : cA + (size_t)(t + 2) * kstep; const char* b2 = last ? nB : cB + (size_t)(t + 2) * kstep;
            const char* a3 = a2 + kstep; const char* b3 = b2 + kstep;
            if (last && has_next) S.a_ready(nxt);
            PG8_LDB(B0, 0, 0); PG8_LDB(B1, 0, 1); PG8_SCHED; PG8_LDA(At, 0, 0); PG8_STAGE(PG8_SA(1, 1), a1 + hstepA, voffA);
            PG8_WAIT_V(8); PG8_WAIT_L(0); PG8_BAR; PG8_MMA(0, 0, At, B0); PG8_MMA(0, 1, At, B1); PG8_BAR; PG8_SCHED;
            PG8_LDA(At, 0, 1); PG8_STAGE(PG8_SB(0, 0), b2, voffB); PG8_STAGE(PG8_SB(0, 1), b2 + hstepB, voffB); PG8_STAGE(PG8_SA(0, 0), a2, voffA);
            PG8_WAIT_V(8); PG8_WAIT_L(0); PG8_BAR; PG8_MMA(1, 0, At, B0); PG8_MMA(1, 1, At, B1); PG8_BAR; PG8_SCHED;
            PG8_LDB(B0, 1, 0); PG8_LDB(B1, 1, 1); PG8_SCHED; PG8_LDA(At, 1, 0); PG8_STAGE(PG8_SA(0, 1), a2 + hstepA, voffA);
            PG8_WAIT_V(8); PG8_WAIT_L(0); PG8_BAR; PG8_MMA(0, 0, At, B0); PG8_MMA(0, 1, At, B1); PG8_BAR; PG8_SCHED;
            PG8_LDA(At, 1, 1); PG8_STAGE(PG8_SB(1, 0), b3, voffB); PG8_STAGE(PG8_SB(1, 1), b3 + hstepB, voffB); PG8_STAGE(PG8_SA(1, 0), a3, voffA);
            PG8_WAIT_V(8); PG8_WAIT_L(0); PG8_BAR; PG8_MMA(1, 0, At, B0); PG8_MMA(1, 1, At, B1); PG8_BAR; PG8_SCHED;
        }
        if constexpr (ALIGN_EPI) { if (wr == 0) PG8_BAR; }
        E(acc, cur, wr, wc, fr, fq); S.done(cur);
        if (!has_next) break;
#pragma unroll
        for (int a = 0; a < 2; ++a)
#pragma unroll
            for (int b = 0; b < 2; ++b)
#pragma unroll
                for (int m = 0; m < 4; ++m)
#pragma unroll
                    for (int n = 0; n < 2; ++n) acc[a][b][m][n] = (f32x4){0.f, 0.f, 0.f, 0.f};
        cur = nxt; cA = nA; cB = nB; ++ui;
        if constexpr (ALIGN_EPI) { if (wr == 1) PG8_BAR; }
    }
    PG8_WAIT_V(0);
    if constexpr (!ALIGN_EPI) { if (wr == 0) PG8_BAR; }
    PG8_BAR;
#undef PG8_SA
#undef PG8_SB
#undef PG8_STAGE
#undef PG8_LDA
#undef PG8_LDB
#undef PG8_MMA
#undef PG8_WAIT_V
#undef PG8_WAIT_L
#undef PG8_BAR
#undef PG8_SCHED
}
}


#ifndef CHECKS
#define CHECKS 0
#endif
constexpr int CW_CHK = 64;
__device__ __forceinline__ float bf2f(bf16 v) { return __builtin_bit_cast(float, (unsigned)v << 16); }
__device__ __forceinline__ bf16 f2bf(float v) { return (bf16)(pk2(v, 0.f) & 0xffffu); }
__device__ __forceinline__ void gemm_check(const Frame& F, const Args& a, const bf16* A, int lda, const bf16* Bt, int K, int N, const void* O, int ldc, int mode,
                                           const float* rscale, const float* base, const float* gate, int k) {
    unsigned s = (unsigned)(F.vcu * NTHR + F.tid);
    const int row = (int)((s * 7919u) % (unsigned)T), col = (int)((s * 104729u) % (unsigned)N);
    float ref = 0.f;
    for (int i = 0; i < K; ++i) ref += bf2f(A[(size_t)row * lda + i]) * bf2f(Bt[(size_t)col * K + i]);
    bool bad;
    if (mode == 0) { const float v = bf2f(((const bf16*)O)[(size_t)row * ldc + col]); const float e = ref * (rscale ? rscale[row] : 1.f); bad = !(fabsf(v - e) <= 0.01f * fabsf(e) + 0.02f); }
    else if (mode == 1) { const float v = ((const float*)O)[(size_t)row * ldc + col]; const float b0 = base[(size_t)row * ldc + col]; const float e = b0 + gate[(size_t)(row >> 12) * 6144 + col] * ref;
        bad = !(fabsf(v - e) <= 1e-3f * (fabsf(b0) + fabsf(e)) + 1e-3f); }
    else { const float v = ((const float*)O)[(size_t)row * ldc + col]; bad = !(fabsf(v - ref) <= 1e-3f * fabsf(ref) + 1e-3f); }
    if (bad) atomicAdd((unsigned*)(a.ws + WS_CTL) + CW_CHK + k, 1u);
}

__device__ __forceinline__ void p3_post(const Frame& F, const Args& a) {
    bf16* proj = (bf16*)(a.ws + WS_PROJ);
    float* rq = (float*)(a.ws + WS_RSTDQ); float* rkv = (float*)(a.ws + WS_RSTDKV);
    const float* ropeA = (const float*)(a.ws + WS_ROPEA); const float* ropeB = (const float*)(a.ws + WS_ROPEB);
    const int lane = F.lane;
    for (int t = F.gw; t < T; t += F.NGW) {
        bf16* row = proj + (size_t)t * AB_INP;
        const u32x2 q = *(const u32x2*)(row + C_QLAT + 4 * lane);
        float s = bf_lo(q.x) * bf_lo(q.x) + bf_hi(q.x) * bf_hi(q.x) + bf_lo(q.y) * bf_lo(q.y) + bf_hi(q.y) * bf_hi(q.y);
        const unsigned kv = *(const unsigned*)(row + C_KVLAT + 2 * lane);
        float s2 = bf_lo(kv) * bf_lo(kv) + bf_hi(kv) * bf_hi(kv);
        s = wave_sum(s, lane); s2 = wave_sum(s2, lane);
        if (lane == 0) { rq[t] = 1.f / sqrtf(s * (1.f / 256.f) + NORM_EPS); rkv[t] = 1.f / sqrtf(s2 * (1.f / 128.f) + NORM_EPS); }
        if (lane < 16) {
            const float x1 = bf2f(row[C_KPE + lane]), x2 = bf2f(row[C_KPE + 16 + lane]);
            const float cs = ropeA[(size_t)t * 32 + lane], sn = ropeA[(size_t)t * 32 + 16 + lane];
            row[C_KPE + lane] = f2bf(x1 * cs - x2 * sn); row[C_KPE + 16 + lane] = f2bf(x2 * cs + x1 * sn);
        }
        { const int c0 = C_BK + (lane >> 2) * 32 + (lane & 3);
          const float x1 = bf2f(row[c0]), x2 = bf2f(row[c0 + 4]);
          const float cs = ropeB[(size_t)t * 8 + (lane & 3)], sn = ropeB[(size_t)t * 8 + 4 + (lane & 3)];
          row[c0] = f2bf(x1 * cs - x2 * sn); row[c0 + 4] = f2bf(x2 * cs + x1 * sn); }
    }
}


namespace att {
constexpr int KST = 208, VST = 192, KTILE = 64 * KST, VTILE = 64 * VST;
constexpr int OFF_K = 0, OFF_V = 2 * KTILE, OFF_BIAS = OFF_V + 2 * VTILE, ATT_LDS = OFF_BIAS + 272 * 4;
constexpr float LOG2E = 1.4426950408889634f;
#define MFMA32(a, b, c) __builtin_amdgcn_mfma_f32_32x32x16_bf16((a), (b), (c), 0, 0, 0)
struct St { f32x16 o0, o1; float m, l; };
__device__ __forceinline__ void st_init(St& s) {
#pragma unroll
    for (int i = 0; i < 16; ++i) { s.o0[i] = 0.f; s.o1[i] = 0.f; }
    s.m = -1e30f; s.l = 0.f;
}
__device__ __forceinline__ bf16x8 pack8(float a0, float a1, float a2, float a3, float a4, float a5, float a6, float a7) {
    u32x4 p; p.x = pk2(a0, a1); p.y = pk2(a2, a3); p.z = pk2(a4, a5); p.w = pk2(a6, a7); return __builtin_bit_cast(bf16x8, p);
}
template <int KS0, int NKS>
__device__ __forceinline__ void qk_tile(const LAS uchar* Kt, int lane, const bf16x8* qf, f32x16& s0, f32x16& s1) {
    const LAS uchar* kp = Kt + (lane & 31) * KST + (lane >> 5) * 16 + KS0 * 32;
#pragma unroll
    for (int i = 0; i < 16; ++i) { s0[i] = 0.f; s1[i] = 0.f; }
#pragma unroll
    for (int ks = 0; ks < NKS; ++ks) {
        const bf16x8 k0 = *(const LAS bf16x8*)(kp + ks * 32), k1 = *(const LAS bf16x8*)(kp + 32 * KST + ks * 32);
        s0 = MFMA32(k0, qf[ks], s0); s1 = MFMA32(k1, qf[ks], s1);
    }
}
template <bool PRE>
__device__ __forceinline__ void softmax_tile(f32x16& s0, f32x16& s1, float c, St& st, bf16x8 (&pf)[2][2], int lane) {
    float mx = s0[0];
#pragma unroll
    for (int i = 1; i < 16; ++i) mx = fmaxf(mx, s0[i]);
#pragma unroll
    for (int i = 0; i < 16; ++i) mx = fmaxf(mx, s1[i]);
    mx = fmaxf(mx, shx(mx, 32, lane));
    const float mnew = fmaxf(st.m, PRE ? mx : mx * c);
    const float alpha = __builtin_amdgcn_exp2f(st.m - mnew);
    st.m = mnew;
    float rs = 0.f;
#pragma unroll
    for (int i = 0; i < 16; ++i) { const float p = __builtin_amdgcn_exp2f(PRE ? (s0[i] - mnew) : __builtin_fmaf(s0[i], c, -mnew)); s0[i] = p; rs += p; }
#pragma unroll
    for (int i = 0; i < 16; ++i) { const float p = __builtin_amdgcn_exp2f(PRE ? (s1[i] - mnew) : __builtin_fmaf(s1[i], c, -mnew)); s1[i] = p; rs += p; }
    st.l = st.l * alpha + rs;
    st.o0 = st.o0 * alpha; st.o1 = st.o1 * alpha;
    pf[0][0] = pack8(s0[0], s0[1], s0[2], s0[3], s0[4], s0[5], s0[6], s0[7]);
    pf[0][1] = pack8(s0[8], s0[9], s0[10], s0[11], s0[12], s0[13], s0[14], s0[15]);
    pf[1][0] = pack8(s1[0], s1[1], s1[2], s1[3], s1[4], s1[5], s1[6], s1[7]);
    pf[1][1] = pack8(s1[8], s1[9], s1[10], s1[11], s1[12], s1[13], s1[14], s1[15]);
}
__device__ __forceinline__ void pv_tile(const LAS uchar* Vt, int lane, const bf16x8 (&pf)[2][2], St& st) {
    const int hh = lane >> 5, q = (lane & 15) >> 2, p = lane & 3, blk = (lane >> 4) & 1;
    const LAS uchar* vb = Vt + (4 * hh + q) * VST + (16 * blk + 4 * p) * 2;
#pragma unroll
    for (int kh = 0; kh < 2; ++kh)
#pragma unroll
        for (int s = 0; s < 2; ++s) {
            const LAS uchar* vp = vb + (32 * kh + 16 * s) * VST;
            const s16x4 lo0 = __builtin_amdgcn_ds_read_tr16_b64_v4i16((LAS s16x4*)(vp)), hi0 = __builtin_amdgcn_ds_read_tr16_b64_v4i16((LAS s16x4*)(vp + 8 * VST));
            const s16x4 lo1 = __builtin_amdgcn_ds_read_tr16_b64_v4i16((LAS s16x4*)(vp + 64)), hi1 = __builtin_amdgcn_ds_read_tr16_b64_v4i16((LAS s16x4*)(vp + 8 * VST + 64));
            const bf16x8 v0 = __builtin_shufflevector(lo0, hi0, 0, 1, 2, 3, 4, 5, 6, 7), v1 = __builtin_shufflevector(lo1, hi1, 0, 1, 2, 3, 4, 5, 6, 7);
            st.o0 = MFMA32(v0, pf[kh][s], st.o0); st.o1 = MFMA32(v1, pf[kh][s], st.o1);
        }
}
struct Tensors { const bf16* Q; const bf16* KV; const bf16* PROJ; const bf16* QKV; bf16* O; const float* ropeA; const float* ropeB; const float* rel_bias; const float* hng; float lam; };

template <int MODE>
__device__ __forceinline__ void attn_unit(const Frame& F, LAS uchar* lds, const Tensors& X, int b, int head, int qt) {
    int tid = F.tid; asm volatile("" : "+v"(tid));
    const int lane = tid & 63, wave = F.wave, hh = lane >> 5;
    constexpr int NQF = MODE == 0 ? 6 : 4;
    const int qrow = b * SEQ + 256 * qt + 32 * wave + (lane & 31);
    bf16x8 qf[NQF];
    {
        const bf16* qp = MODE == 0 ? X.Q + (size_t)qrow * 768 + head * 96 + 8 * hh : MODE == 1 ? X.PROJ + (size_t)qrow * AB_INP + C_BQ + head * 64 + 8 * hh : X.QKV + (size_t)qrow * 3072 + head * 64 + 8 * hh;
#pragma unroll
        for (int ks = 0; ks < NQF; ++ks) qf[ks] = *(const bf16x8*)(qp + 16 * ks);
        if (MODE == 0) {
            const float* rp = X.ropeA + (size_t)qrow * 32 + 8 * hh;
            const f32x4 c0 = *(const f32x4*)rp, c1 = *(const f32x4*)(rp + 4), s0 = *(const f32x4*)(rp + 16), s1 = *(const f32x4*)(rp + 20);
            float cs[8] = {c0.x, c0.y, c0.z, c0.w, c1.x, c1.y, c1.z, c1.w}, sn[8] = {s0.x, s0.y, s0.z, s0.w, s1.x, s1.y, s1.z, s1.w};
            float o1[8], o2[8];
#pragma unroll
            for (int j = 0; j < 8; ++j) { const float x1 = bf2f((bf16)qf[4][j]), x2 = bf2f((bf16)qf[5][j]); o1[j] = x1 * cs[j] - x2 * sn[j]; o2[j] = x2 * cs[j] + x1 * sn[j]; }
            qf[4] = pack8(o1[0], o1[1], o1[2], o1[3], o1[4], o1[5], o1[6], o1[7]); qf[5] = pack8(o2[0], o2[1], o2[2], o2[3], o2[4], o2[5], o2[6], o2[7]);
        }
        if (MODE == 1) {
            const float* rp = X.ropeB + (size_t)qrow * 8;
            const f32x4 c = *(const f32x4*)rp, s = *(const f32x4*)(rp + 4);
            const float cs[4] = {c.x, c.y, c.z, c.w}, sn[4] = {s.x, s.y, s.z, s.w};
#pragma unroll
            for (int f = 0; f < 4; f += 2) {
                float v[8];
#pragma unroll
                for (int j = 0; j < 8; ++j) v[j] = bf2f((bf16)qf[f][j]);
                float o[8];
#pragma unroll
                for (int j = 0; j < 4; ++j) { o[j] = v[j] * cs[j] - v[j + 4] * sn[j]; o[j + 4] = v[j + 4] * cs[j] + v[j] * sn[j]; }
                const bf16x8 r = pack8(o[0], o[1], o[2], o[3], o[4], o[5], o[6], o[7]);
                if (hh == 0) qf[f] = r;
            }
        }
    }
    const int key = tid >> 3, ch = tid & 7;
    const char* kvbase = (const char*)(MODE == 0 ? X.KV : MODE == 1 ? X.PROJ : X.QKV);
    unsigned koff, voff, poff = 0u, tstride, pstride = 0u;
    if (MODE == 0) { koff = (unsigned)((b * SEQ + key) * 1024 + head * 128 + ch * 8) * 2u; voff = koff + 128u; tstride = 64u * 1024u * 2u;
                     poff = (unsigned)((b * SEQ + (tid >> 2)) * AB_INP + C_KPE + (tid & 3) * 8) * 2u; pstride = 64u * AB_INP * 2u; }
    else if (MODE == 1) { koff = (unsigned)((b * SEQ + key) * AB_INP + C_BK + head * 64 + ch * 8) * 2u; voff = koff + (unsigned)(C_BV - C_BK) * 2u; tstride = 64u * AB_INP * 2u; }
    else { koff = (unsigned)((b * SEQ + key) * 3072 + 1024 + head * 64 + ch * 8) * 2u; voff = koff + 2048u; tstride = 64u * 3072u * 2u; }
    const char* pbase = (const char*)X.PROJ;
    const int kdst = key * KST + ch * 16, vdst = key * VST + ch * 16, pdst = (tid >> 2) * KST + 128 + (tid & 3) * 16;
    const int jlo = MODE == 2 ? (4 * qt - 8 > 0 ? 4 * qt - 8 : 0) : 0, jhi = 4 * qt + 3, cw = 4 * qt + (wave >> 1);
    const float c = (MODE == 0 ? 0.10206207261596575f : MODE == 1 ? 0.17677669529663687f : 0.125f) * LOG2E;
    LAS float* biasT = (LAS float*)(lds + OFF_BIAS);
    if (MODE == 2) { if (tid < 257) biasT[tid] = X.rel_bias[head * 257 + tid] * LOG2E; }
    St st1, st2; st_init(st1); if (MODE == 1) st_init(st2);
    u32x4 rk, rv, rp4;
    rk = *(const u32x4*)(kvbase + (koff + (unsigned)jlo * tstride)); rv = *(const u32x4*)(kvbase + (voff + (unsigned)jlo * tstride));
    if (MODE == 0 && tid < 256) rp4 = *(const u32x4*)(pbase + (poff + (unsigned)jlo * pstride));
    *(LAS u32x4*)(lds + OFF_K + kdst) = rk; *(LAS u32x4*)(lds + OFF_V + vdst) = rv;
    if (MODE == 0 && tid < 256) *(LAS u32x4*)(lds + OFF_K + pdst) = rp4;
    __syncthreads();
    for (int j = jlo; j <= jhi; ++j) {
        const int stg = (j - jlo) & 1;
        if (j < jhi) { rk = *(const u32x4*)(kvbase + (koff + (unsigned)(j + 1) * tstride)); rv = *(const u32x4*)(kvbase + (voff + (unsigned)(j + 1) * tstride));
                       if (MODE == 0 && tid < 256) rp4 = *(const u32x4*)(pbase + (poff + (unsigned)(j + 1) * pstride)); }
        const bool active = (j <= cw) && (MODE != 2 || j >= cw - 8);
        if (active) {
            const LAS uchar* Kt = lds + OFF_K + stg * KTILE; const LAS uchar* Vt = lds + OFF_V + stg * VTILE;
            f32x16 s0, s1; bf16x8 pf[2][2];
            if (MODE == 0) { qk_tile<0, 6>(Kt, lane, qf, s0, s1); softmax_tile<false>(s0, s1, c, st1, pf, lane); pv_tile(Vt, lane, pf, st1); }
            else if (MODE == 1) {
                qk_tile<0, 2>(Kt, lane, qf, s0, s1); softmax_tile<false>(s0, s1, c, st1, pf, lane); pv_tile(Vt, lane, pf, st1);
                qk_tile<2, 2>(Kt, lane, qf + 2, s0, s1); softmax_tile<false>(s0, s1, c, st2, pf, lane); pv_tile(Vt, lane, pf, st2);
            } else {
                qk_tile<0, 4>(Kt, lane, qf, s0, s1);
                if (cw - j >= 3) { const float bc = biasT[256];
#pragma unroll
                    for (int i = 0; i < 16; ++i) { s0[i] = __builtin_fmaf(s0[i], c, bc); s1[i] = __builtin_fmaf(s1[i], c, bc); } }
                else { const int qoff = 256 * qt + 32 * wave + (lane & 31) - 64 * j + 128 - 4 * hh;
#pragma unroll
                    for (int i = 0; i < 16; ++i) { const int kk = (i & 3) + 8 * (i >> 2);
                        int i0 = qoff - kk; i0 = i0 < 0 ? 0 : (i0 > 256 ? 256 : i0); int i1 = qoff - kk - 32; i1 = i1 < 0 ? 0 : (i1 > 256 ? 256 : i1);
                        s0[i] = __builtin_fmaf(s0[i], c, biasT[i0]); s1[i] = __builtin_fmaf(s1[i], c, biasT[i1]); } }
                softmax_tile<true>(s0, s1, 1.f, st1, pf, lane); pv_tile(Vt, lane, pf, st1);
            }
        }
        if (j < jhi) { *(LAS u32x4*)(lds + OFF_K + (stg ^ 1) * KTILE + kdst) = rk; *(LAS u32x4*)(lds + OFF_V + (stg ^ 1) * VTILE + vdst) = rv;
                       if (MODE == 0 && tid < 256) *(LAS u32x4*)(lds + OFF_K + (stg ^ 1) * KTILE + pdst) = rp4; }
        __syncthreads();
    }
    if (MODE != 1) {
        const float inv = 1.f / (st1.l + shx(st1.l, 32, lane));
        bf16* op = X.O + (size_t)qrow * 1024 + head * 64 + 4 * hh;
#pragma unroll
        for (int g = 0; g < 4; ++g) {
            u32x2 w0; w0.x = pk2(st1.o0[4 * g] * inv, st1.o0[4 * g + 1] * inv); w0.y = pk2(st1.o0[4 * g + 2] * inv, st1.o0[4 * g + 3] * inv); *(u32x2*)(op + 8 * g) = w0;
            u32x2 w1; w1.x = pk2(st1.o1[4 * g] * inv, st1.o1[4 * g + 1] * inv); w1.y = pk2(st1.o1[4 * g + 2] * inv, st1.o1[4 * g + 3] * inv); *(u32x2*)(op + 32 + 8 * g) = w1;
        }
    } else {
        const float i1 = 1.f / (st1.l + shx(st1.l, 32, lane)), i2 = X.lam / (st2.l + shx(st2.l, 32, lane));
        float ss = 0.f;
#pragma unroll
        for (int i = 0; i < 16; ++i) { st1.o0[i] = st1.o0[i] * i1 - st2.o0[i] * i2; st1.o1[i] = st1.o1[i] * i1 - st2.o1[i] * i2; ss += st1.o0[i] * st1.o0[i] + st1.o1[i] * st1.o1[i]; }
        ss += shx(ss, 32, lane);
        const float r = 0.8f / sqrtf(ss * (1.f / 64.f) + NORM_EPS);
        bf16* op = X.O + (size_t)qrow * 1024 + 512 + head * 64 + 4 * hh;
        const float* gp = X.hng + 4 * hh;
#pragma unroll
        for (int g = 0; g < 4; ++g) {
            const f32x4 g0 = *(const f32x4*)(gp + 8 * g), g1 = *(const f32x4*)(gp + 32 + 8 * g);
            u32x2 w0; w0.x = pk2(st1.o0[4 * g] * r * g0.x, st1.o0[4 * g + 1] * r * g0.y); w0.y = pk2(st1.o0[4 * g + 2] * r * g0.z, st1.o0[4 * g + 3] * r * g0.w); *(u32x2*)(op + 8 * g) = w0;
            u32x2 w1; w1.x = pk2(st1.o1[4 * g] * r * g1.x, st1.o1[4 * g + 1] * r * g1.y); w1.y = pk2(st1.o1[4 * g + 2] * r * g1.z, st1.o1[4 * g + 3] * r * g1.w); *(u32x2*)(op + 32 + 8 * g) = w1;
        }
    }
}
#if CHECKS
template <int MODE>
__device__ __forceinline__ float chk_q(const Tensors& X, int qrow, int head, int sub, int e) {
    if (MODE == 0) { const bf16* qp = X.Q + (size_t)qrow * 768 + head * 96;
        if (e < 64) return bf2f(qp[e]);
        const int i = (e - 64) & 15; const float cs = X.ropeA[(size_t)qrow * 32 + i], sn = X.ropeA[(size_t)qrow * 32 + 16 + i]; const float x1 = bf2f(qp[64 + i]), x2 = bf2f(qp[80 + i]);
        return bf2f(f2bf(e < 80 ? x1 * cs - x2 * sn : x2 * cs + x1 * sn)); }
    if (MODE == 1) { const bf16* qp = X.PROJ + (size_t)qrow * AB_INP + C_BQ + head * 64 + sub * 32;
        if (e >= 8) return bf2f(qp[e]);
        const int i = e & 3; const float cs = X.ropeB[(size_t)qrow * 8 + i], sn = X.ropeB[(size_t)qrow * 8 + 4 + i]; const float x1 = bf2f(qp[i]), x2 = bf2f(qp[4 + i]);
        return bf2f(f2bf(e < 4 ? x1 * cs - x2 * sn : x2 * cs + x1 * sn)); }
    return bf2f(X.QKV[(size_t)qrow * 3072 + head * 64 + e]);
}
template <int MODE>
__device__ __forceinline__ float chk_score(const Tensors& X, int b, int q, int qrow, int head, int sub, int kk) {
    const int dq = MODE == 0 ? 96 : MODE == 1 ? 32 : 64; const int krow = b * SEQ + kk; float d = 0.f;
    for (int e = 0; e < dq; ++e) { float kvv;
        if (MODE == 0) kvv = e < 64 ? bf2f(X.KV[(size_t)krow * 1024 + head * 128 + e]) : bf2f(X.PROJ[(size_t)krow * AB_INP + C_KPE + (e - 64)]);
        else if (MODE == 1) kvv = bf2f(X.PROJ[(size_t)krow * AB_INP + C_BK + head * 64 + sub * 32 + e]);
        else kvv = bf2f(X.QKV[(size_t)krow * 3072 + 1024 + head * 64 + e]);
        d += chk_q<MODE>(X, qrow, head, sub, e) * kvv; }
    d *= (MODE == 0 ? 0.10206207261596575f : MODE == 1 ? 0.17677669529663687f : 0.125f);
    if (MODE == 2) { int rel = q - kk; rel = rel < -128 ? -128 : (rel > 128 ? 128 : rel); d += X.rel_bias[head * 257 + rel + 128]; }
    return d;
}
template <int MODE>
__device__ __forceinline__ float chk_attn1(const Tensors& X, int b, int q, int head, int sub, int lane) {
    const int qrow = b * SEQ + q, chunk = q >> 6;
    const int klo = MODE == 2 ? (chunk - 8 > 0 ? (chunk - 8) * 64 : 0) : 0, khi = (chunk + 1) * 64;
    float mx = -1e30f;
    for (int k0 = klo; k0 < khi; k0 += 64) mx = fmaxf(mx, chk_score<MODE>(X, b, q, qrow, head, sub, k0 + lane));
#pragma unroll
    for (int o = 1; o < 64; o <<= 1) mx = fmaxf(mx, shx(mx, o, lane));
    float den = 0.f, acc = 0.f;
    for (int k0 = klo; k0 < khi; k0 += 64) {
        const float p = __expf(chk_score<MODE>(X, b, q, qrow, head, sub, k0 + lane) - mx); den += p;
        for (int i = 0; i < 64; ++i) { const float pi = __builtin_bit_cast(float, __builtin_amdgcn_readlane(__builtin_bit_cast(int, p), i)); const int krow = b * SEQ + k0 + i;
            const float vv = MODE == 0 ? bf2f(X.KV[(size_t)krow * 1024 + head * 128 + 64 + lane]) : MODE == 1 ? bf2f(X.PROJ[(size_t)krow * AB_INP + C_BV + head * 64 + lane]) : bf2f(X.QKV[(size_t)krow * 3072 + 2048 + head * 64 + lane]);
            acc += pi * vv; }
    }
    return acc / wave_sum(den, lane);
}
template <int MODE>
__device__ __forceinline__ void attn_check(const Frame& F, const Args& a, const Tensors& X, int k) {
    unsigned s = (unsigned)F.gw; asm volatile("" : "+s"(s));
    const int lane = F.lane;
    const int b = (int)(s % 8u), head = (int)((s / 8u) % (MODE == 2 ? 16u : 8u)), q = (int)((s * 2654435761u) >> 20) & 4095;
    float o = chk_attn1<MODE>(X, b, q, head, 0, lane);
    if (MODE == 1) { o -= X.lam * chk_attn1<MODE>(X, b, q, head, 1, lane); const float ss = wave_sum(o * o, lane); o *= 0.8f / sqrtf(ss / 64.f + NORM_EPS) * X.hng[lane]; }
    const float got = bf2f(X.O[(size_t)(b * SEQ + q) * 1024 + (MODE == 1 ? 512 : 0) + head * 64 + lane]);
    const bool bad = !(fabsf(got - o) <= 0.03f * fabsf(o) + 0.02f);
    if (__ballot(bad) != 0ull && lane == 0) atomicAdd((unsigned*)(a.ws + WS_CTL) + CW_CHK + k, 1u);
}
#endif
}


namespace peer {
constexpr int OFF_TAB = 16384;
__device__ __forceinline__ unsigned mono(float f) { const unsigned u = __builtin_bit_cast(unsigned, f); return u ^ ((unsigned)((int)u >> 31) | 0x80000000u); }
__device__ __forceinline__ float demono(unsigned k) { const unsigned u = (k & 0x80000000u) ? (k ^ 0x80000000u) : ~k; return __builtin_bit_cast(float, u); }
__device__ __forceinline__ unsigned umax(unsigned a, unsigned b) { return a > b ? a : b; }
__device__ __forceinline__ unsigned umin(unsigned a, unsigned b) { return a < b ? a : b; }
__device__ __forceinline__ unsigned shxu(unsigned v, int mask, int lane) { return (unsigned)__builtin_amdgcn_ds_bpermute((lane ^ mask) << 2, (int)v); }
template <int N> __device__ __forceinline__ void bitonic_merge_desc(unsigned (&a)[N]) {
#pragma unroll
    for (int j = N / 2; j > 0; j >>= 1)
#pragma unroll
        for (int i = 0; i < N; ++i) { const int l = i ^ j; if (l > i) { const unsigned hi = umax(a[i], a[l]), lo = umin(a[i], a[l]); a[i] = hi; a[l] = lo; } }
}
template <int N> __device__ __forceinline__ void bitonic_sort_desc(unsigned (&a)[N]) {
#pragma unroll
    for (int k = 2; k <= N; k <<= 1)
#pragma unroll
        for (int j = k >> 1; j > 0; j >>= 1)
#pragma unroll
            for (int i = 0; i < N; ++i) { const int l = i ^ j; if (l > i) { const bool desc = ((i & k) == 0) || (k == N);
                const unsigned hi = umax(a[i], a[l]), lo = umin(a[i], a[l]); a[i] = desc ? hi : lo; a[l] = desc ? lo : hi; } }
}
__device__ __forceinline__ void merge_partner16(unsigned (&a)[16], int mask, int lane) {
    unsigned p[16];
#pragma unroll
    for (int i = 0; i < 16; ++i) p[i] = shxu(a[i], mask, lane);
#pragma unroll
    for (int i = 0; i < 16; ++i) a[i] = umax(a[i], p[15 - i]);
    bitonic_merge_desc<16>(a);
}
__device__ __forceinline__ float dot2bf(unsigned a, unsigned b, float c) { return __builtin_amdgcn_fdot2_f32_bf16(__builtin_bit_cast(bf2v, a), __builtin_bit_cast(bf2v, b), c, false); }
__device__ __forceinline__ float gelu_exact(float z) { return 0.5f * z * (1.f + erff(z * 0.70710678118654752f)); }

struct P { const float* SC; const bf16* H; const bf16* EU; const bf16* EV; float* X; const float* gate_f;
           const float* ng; const float* nsc; const float* nsh;   bf16* Hout; };

template <bool FINAL>
__device__ __forceinline__ void peer_phase(const Frame& F, const P& p) {
    const int lane = F.lane;
    LAS unsigned* keys1 = (LAS unsigned*)(F.lds + RING_OFF + F.wave * 2048);
    LAS unsigned* keys2 = keys1 + 256;
    LAS uchar* tab = F.lds + RING_OFF + OFF_TAB;
    if (F.tid < 64) { int cnt = 0, code = 0xFF;
#pragma unroll
        for (int i = 0; i < 16; ++i) { const int n = 16 / (i + 1); if (F.tid >= cnt && F.tid < cnt + n) code = (i << 4) | (F.tid - cnt); cnt += n; }
        tab[F.tid] = (uchar)code; }
    __syncthreads();
    for (int t = F.gw; t < T; t += F.NGW) {
        const int b = t >> 12;
        float acc[16];
        for (int rep = 0; rep < REP_PEER; ++rep) {
        unsigned a[16], c2[16];
        { const int g = lane >> 2, i4 = lane & 3; const f32x4* sp = (const f32x4*)(p.SC + (size_t)t * 2048 + g * 128) + i4;
#pragma unroll
          for (int k = 0; k < 4; ++k) { const f32x4 v = sp[4 * k]; const int n0 = 16 * k + 4 * i4;
              a[4 * k + 0] = (mono(v.x) & ~127u) | (unsigned)(127 - (n0 + 0)); a[4 * k + 1] = (mono(v.y) & ~127u) | (unsigned)(127 - (n0 + 1));
              a[4 * k + 2] = (mono(v.z) & ~127u) | (unsigned)(127 - (n0 + 2)); a[4 * k + 3] = (mono(v.w) & ~127u) | (unsigned)(127 - (n0 + 3)); }
#pragma unroll
          for (int k = 4; k < 8; ++k) { const f32x4 v = sp[4 * k]; const int n0 = 16 * k + 4 * i4;
              c2[4 * (k - 4) + 0] = (mono(v.x) & ~127u) | (unsigned)(127 - (n0 + 0)); c2[4 * (k - 4) + 1] = (mono(v.y) & ~127u) | (unsigned)(127 - (n0 + 1));
              c2[4 * (k - 4) + 2] = (mono(v.z) & ~127u) | (unsigned)(127 - (n0 + 2)); c2[4 * (k - 4) + 3] = (mono(v.w) & ~127u) | (unsigned)(127 - (n0 + 3)); } }
        bitonic_sort_desc<16>(a); bitonic_sort_desc<16>(c2);
#pragma unroll
        for (int i = 0; i < 16; ++i) a[i] = umax(a[i], c2[15 - i]);
        bitonic_merge_desc<16>(a);
        merge_partner16(a, 1, lane); merge_partner16(a, 2, lane);
        if ((lane & 3) == 0) {
#pragma unroll
            for (int i = 0; i < 4; ++i) *(LAS u32x4*)(keys1 + (lane >> 2) * 16 + 4 * i) = (u32x4){a[4 * i], a[4 * i + 1], a[4 * i + 2], a[4 * i + 3]}; }
        LDS_WAIT();
        { const int hd = lane >> 3, sl = lane & 7; unsigned x[16];
#pragma unroll
          for (int jj = 0; jj < 8; ++jj) { const unsigned code = tab[sl * 8 + jj]; const unsigned i = (code >> 4) & 15u, j = code & 15u;
              const unsigned k0 = keys1[(2 * hd) * 16 + i], k1 = keys1[(2 * hd + 1) * 16 + j];
              const float s = demono(k0 & ~127u) + demono(k1 & ~127u);
              x[jj] = code == 0xFFu ? 0u : ((mono(s) & ~255u) | (255u - code)); }
          { unsigned y[8];
#pragma unroll
            for (int i = 0; i < 8; ++i) y[i] = x[i];
            bitonic_sort_desc<8>(y);
#pragma unroll
            for (int i = 0; i < 8; ++i) x[i] = y[i];
#pragma unroll
            for (int i = 0; i < 8; ++i) x[8 + i] = shxu(y[7 - i], 1, lane); }
          bitonic_merge_desc<16>(x);
          merge_partner16(x, 2, lane); merge_partner16(x, 4, lane);
          if (sl == 0) {
#pragma unroll
              for (int i = 0; i < 4; ++i) *(LAS u32x4*)(keys2 + hd * 16 + 4 * i) = (u32x4){x[4 * i], x[4 * i + 1], x[4 * i + 2], x[4 * i + 3]}; } }
        LDS_WAIT();
        int eid0, eid1; float g0, g1;
        { const int r = lane & 15;
#pragma unroll
          for (int hs = 0; hs < 2; ++hs) { const int hd = (lane >> 4) + 4 * hs;
              const unsigned ck = keys2[hd * 16 + r]; const unsigned flat = 255u - (ck & 255u); const unsigned i = flat >> 4, j = flat & 15u;
              const unsigned k0 = keys1[(2 * hd) * 16 + i], k1 = keys1[(2 * hd + 1) * 16 + j];
              const int eid = (int)((127u - (k0 & 127u)) * 128u + (127u - (k1 & 127u)));
              const float s = demono(k0 & ~127u) + demono(k1 & ~127u);
              float mx = s; mx = fmaxf(mx, shx(mx, 1, lane)); mx = fmaxf(mx, shx(mx, 2, lane)); mx = fmaxf(mx, shx(mx, 4, lane)); mx = fmaxf(mx, shx(mx, 8, lane));
              const float e = __expf(s - mx); float sum = e; sum += shx(sum, 1, lane); sum += shx(sum, 2, lane); sum += shx(sum, 4, lane); sum += shx(sum, 8, lane);
              if (hs == 0) { eid0 = eid; g0 = e / sum; } else { eid1 = eid; g1 = e / sum; } } }
        u32x4 h0, h1;
        { const u32x4* hp = (const u32x4*)(p.H + (size_t)t * 1024) + lane; h0 = hp[0]; h1 = hp[64]; }
        float z0 = 0.f, z1 = 0.f;
        for (int bt = 0; bt < 16; ++bt) {
            const int ev = bt < 8 ? eid0 : eid1;
            u32x4 r0[8], r1[8];
#pragma unroll
            for (int e = 0; e < 8; ++e) { const int eid = __builtin_amdgcn_readlane(ev, ((bt & 7) << 3) + e);
                const u32x4* rp = (const u32x4*)(p.EU + (size_t)eid * 1024) + lane; r0[e] = rp[0]; r1[e] = rp[64]; }
            float pz[8];
#pragma unroll
            for (int e = 0; e < 8; ++e) { float d = 0.f;
#pragma unroll
                for (int i = 0; i < 4; ++i) { d = dot2bf(r0[e][i], h0[i], d); d = dot2bf(r1[e][i], h1[i], d); }
                pz[e] = d; }
            float q4[4], q2[2];
#pragma unroll
            for (int i = 0; i < 4; ++i) { const bool up = (lane & 4) != 0; const float keep = up ? pz[i + 4] : pz[i], send = up ? pz[i] : pz[i + 4]; q4[i] = keep + shx(send, 4, lane); }
#pragma unroll
            for (int i = 0; i < 2; ++i) { const bool up = (lane & 2) != 0; const float keep = up ? q4[i + 2] : q4[i], send = up ? q4[i] : q4[i + 2]; q2[i] = keep + shx(send, 2, lane); }
            float s; { const bool up = (lane & 1) != 0; const float keep = up ? q2[1] : q2[0], send = up ? q2[0] : q2[1]; s = keep + shx(send, 1, lane); }
            s += shx(s, 8, lane); s += shx(s, 16, lane); s += shx(s, 32, lane);
            const bool mine = (lane >> 3) == (bt & 7);
            if (bt < 8) z0 = mine ? s : z0; else z1 = mine ? s : z1;
        }
        const float a0 = gelu_exact(z0) * g0, a1 = gelu_exact(z1) * g1;
#pragma unroll
        for (int i = 0; i < 16; ++i) acc[i] = 0.f;
        for (int bt = 0; bt < 16; ++bt) {
            const int ev = bt < 8 ? eid0 : eid1; const float av = bt < 8 ? a0 : a1;
            u32x4 r0[8], r1[8]; float ak[8];
#pragma unroll
            for (int e = 0; e < 8; ++e) { const int sl = ((bt & 7) << 3) + e; const int eid = __builtin_amdgcn_readlane(ev, sl);
                ak[e] = __builtin_bit_cast(float, __builtin_amdgcn_readlane(__builtin_bit_cast(int, av), sl));
                const u32x4* rp = (const u32x4*)(p.EV + (size_t)eid * 1024) + lane; r0[e] = rp[0]; r1[e] = rp[64]; }
#pragma unroll
            for (int e = 0; e < 8; ++e)
#pragma unroll
                for (int i = 0; i < 4; ++i) { acc[2 * i] = __builtin_fmaf(ak[e], bf_lo(r0[e][i]), acc[2 * i]); acc[2 * i + 1] = __builtin_fmaf(ak[e], bf_hi(r0[e][i]), acc[2 * i + 1]);
                                              acc[8 + 2 * i] = __builtin_fmaf(ak[e], bf_lo(r1[e][i]), acc[8 + 2 * i]); acc[8 + 2 * i + 1] = __builtin_fmaf(ak[e], bf_hi(r1[e][i]), acc[8 + 2 * i + 1]); }
        }
        if (REP_PEER > 1) { LDS_WAIT(); asm volatile("" ::: "memory"); }
        }
        float* xr = p.X + (size_t)t * 1024 + 8 * lane; const float* gf = p.gate_f + (size_t)b * 6144 + 8 * lane;
        f32x4 xv[4]; float ss = 0.f;
#pragma unroll
        for (int i = 0; i < 4; ++i) { const int o = (i >> 1) * 512 + (i & 1) * 4; const f32x4 xo = *(const f32x4*)(xr + o), gg = *(const f32x4*)(gf + o);
            const f32x4 y = {acc[(i >> 1) * 8 + (i & 1) * 4 + 0], acc[(i >> 1) * 8 + (i & 1) * 4 + 1], acc[(i >> 1) * 8 + (i & 1) * 4 + 2], acc[(i >> 1) * 8 + (i & 1) * 4 + 3]};
            xv[i] = xo + gg * y; ss += (xv[i].x * xv[i].x + xv[i].y * xv[i].y) + (xv[i].z * xv[i].z + xv[i].w * xv[i].w); }
        const float rstd = 1.f / sqrtf(wave_sum(ss, lane) * (1.f / 1024.f) + NORM_EPS);
        if (FINAL) {
#pragma unroll
            for (int i = 0; i < 4; ++i) { const int o = (i >> 1) * 512 + (i & 1) * 4; *(f32x4*)(xr + o) = (xv[i] * rstd) * *(const f32x4*)(p.ng + 8 * lane + o); }
        } else {
            u32x4 hw[2];
#pragma unroll
            for (int i = 0; i < 4; ++i) { const int o = (i >> 1) * 512 + (i & 1) * 4; *(f32x4*)(xr + o) = xv[i];
                const f32x4 gg = *(const f32x4*)(p.ng + 8 * lane + o), sc = *(const f32x4*)(p.nsc + (size_t)b * 6144 + 8 * lane + o), sh = *(const f32x4*)(p.nsh + (size_t)b * 6144 + 8 * lane + o);
                const f32x4 y = (xv[i] * rstd) * gg * (sc + 1.0f) + sh;
                hw[i >> 1][(i & 1) * 2] = pk2(y.x, y.y); hw[i >> 1][(i & 1) * 2 + 1] = pk2(y.z, y.w); }
            u32x4* ho = (u32x4*)(p.Hout + (size_t)t * 1024) + lane; ho[0] = hw[0]; ho[64] = hw[1];
        }
    }
}

#if CHECKS
__device__ __forceinline__ void peer_naive(const Frame& F, const P& p) {
    const int lane = F.lane;
    LAS unsigned* selc = (LAS unsigned*)(F.lds + RING_OFF + F.wave * 2048);
    LAS float* selv = (LAS float*)(selc + 128);
    for (int t = F.gw; t < T; t += F.NGW) {
        const int b = t >> 12; const float* sc = p.SC + (size_t)t * 2048;
        for (int hd = 0; hd < 8; ++hd) {
            float pv = 3e38f; int pc = -1;
            for (int r = 0; r < 16; ++r) {
                float bv = -3e38f; int bc = 0x7fffffff;
                for (int m = 0; m < 256; ++m) { const int c = lane + 64 * m; const float v = sc[(2 * hd) * 128 + (c >> 7)] + sc[(2 * hd + 1) * 128 + (c & 127)];
                    const bool after = (v < pv) || (v == pv && c > pc); const bool better = (v > bv) || (v == bv && c < bc);
                    if (after && better) { bv = v; bc = c; } }
#pragma unroll
                for (int o = 1; o < 64; o <<= 1) { const float ov = shx(bv, o, lane); const int oc = (int)shxu((unsigned)bc, o, lane); if (ov > bv || (ov == bv && oc < bc)) { bv = ov; bc = oc; } }
                pv = bv; pc = bc;
                if (lane == 0) { selc[hd * 16 + r] = (unsigned)bc; selv[hd * 16 + r] = bv; }
            }
        }
        LDS_WAIT();
        float acc[16];
#pragma unroll
        for (int i = 0; i < 16; ++i) acc[i] = 0.f;
        const u32x4* hp = (const u32x4*)(p.H + (size_t)t * 1024) + lane; const u32x4 h0 = hp[0], h1 = hp[64];
        for (int hd = 0; hd < 8; ++hd) {
            float mx = -3e38f; for (int r = 0; r < 16; ++r) mx = fmaxf(mx, selv[hd * 16 + r]);
            float den = 0.f; for (int r = 0; r < 16; ++r) den += __expf(selv[hd * 16 + r] - mx);
            for (int r = 0; r < 16; ++r) {
                const int eid = (int)selc[hd * 16 + r]; const float gate = __expf(selv[hd * 16 + r] - mx) / den;
                const u32x4* up = (const u32x4*)(p.EU + (size_t)eid * 1024) + lane; const u32x4 u0 = up[0], u1 = up[64];
                float d = 0.f;
#pragma unroll
                for (int i = 0; i < 4; ++i) d += bf_lo(u0[i]) * bf_lo(h0[i]) + bf_hi(u0[i]) * bf_hi(h0[i]) + bf_lo(u1[i]) * bf_lo(h1[i]) + bf_hi(u1[i]) * bf_hi(h1[i]);
                const float z = wave_sum(d, lane); const float a = gelu_exact(z) * gate;
                const u32x4* vp = (const u32x4*)(p.EV + (size_t)eid * 1024) + lane; const u32x4 v0 = vp[0], v1 = vp[64];
#pragma unroll
                for (int i = 0; i < 4; ++i) { acc[2 * i] += a * bf_lo(v0[i]); acc[2 * i + 1] += a * bf_hi(v0[i]); acc[8 + 2 * i] += a * bf_lo(v1[i]); acc[8 + 2 * i + 1] += a * bf_hi(v1[i]); }
            }
        }
        float* xr = p.X + (size_t)t * 1024 + 8 * lane; const float* gf = p.gate_f + (size_t)b * 6144 + 8 * lane;
        f32x4 xv[4]; float ss = 0.f;
#pragma unroll
        for (int i = 0; i < 4; ++i) { const int o = (i >> 1) * 512 + (i & 1) * 4; const f32x4 xo = *(const f32x4*)(xr + o), gg = *(const f32x4*)(gf + o);
            const f32x4 y = {acc[(i >> 1) * 8 + (i & 1) * 4 + 0], acc[(i >> 1) * 8 + (i & 1) * 4 + 1], acc[(i >> 1) * 8 + (i & 1) * 4 + 2], acc[(i >> 1) * 8 + (i & 1) * 4 + 3]};
            xv[i] = xo + gg * y; ss += (xv[i].x * xv[i].x + xv[i].y * xv[i].y) + (xv[i].z * xv[i].z + xv[i].w * xv[i].w); }
        const float rstd = 1.f / sqrtf(wave_sum(ss, lane) * (1.f / 1024.f) + NORM_EPS);
#pragma unroll
        for (int i = 0; i < 4; ++i) { const int o = (i >> 1) * 512 + (i & 1) * 4; *(f32x4*)(xr + o) = (xv[i] * rstd) * *(const f32x4*)(p.ng + 8 * lane + o); }
        LDS_WAIT();
    }
}
__device__ __forceinline__ void prologue_check(const Frame& F, const Args& a, int k) {
    const unsigned s = (unsigned)(F.vcu * NTHR + F.tid);
    { const int l = (int)(s & 1u), row = (int)((s * 7919u) % 2048u), kk = (int)((s * 104729u) % 1024u); const int hp = row >> 7, n = row & 127;
      float ref = 0.f; for (int d = 0; d < 128; ++d) ref += a.peer_sub_keys[((size_t)(l * 16 + hp) * 128 + n) * 128 + d] * a.peer_w_q[(size_t)l * 1024 * 2048 + (size_t)kk * 2048 + hp * 128 + d];
      const float got = bf2f(((const bf16*)(a.ws + WS_WCOMB))[(size_t)l * 2048 * 1024 + (size_t)row * 1024 + kk]);
      if (!(fabsf(got - ref) <= 0.01f * fabsf(ref) + 1e-3f)) atomicAdd((unsigned*)(a.ws + WS_CTL) + CW_CHK + k, 1u); }
    { const size_t i = ((size_t)s * 2654435761u) % ((size_t)16384 * 1024);
      const float gu = bf2f(((const bf16*)(a.ws + WS_EU))[i]), gv = bf2f(((const bf16*)(a.ws + WS_EV))[i]); const float ru = a.peer_u[i], rv = a.peer_v[i];
      if (!(fabsf(gu - ru) <= 0.01f * fabsf(ru) + 1e-6f) || !(fabsf(gv - rv) <= 0.01f * fabsf(rv) + 1e-6f)) atomicAdd((unsigned*)(a.ws + WS_CTL) + CW_CHK + k, 1u); }
}
#endif
}


namespace peer2 {
using peer::mono; using peer::demono; using peer::umax; using peer::umin; using peer::shxu; using peer::bitonic_merge_desc; using peer::bitonic_sort_desc; using peer::merge_partner16; using peer::gelu_exact;
constexpr int OFF_TAB = 16384;
__device__ __forceinline__ void convert_tables_q(const Frame& F, const Args& a) {
    const int lane = F.lane;
    float* scl = (float*)(a.ws + WS_SCL);
    for (int rr = F.gw; rr < 65536; rr += F.NGW) {
        const int l = rr >> 15, tb = (rr >> 14) & 1, eid = rr & 16383;
        const float* srow = (tb ? a.peer_v : a.peer_u) + ((size_t)l * 16384 + eid) * 1024 + 16 * lane;
        f32x4 v[4]; float mx = 0.f;
#pragma unroll
        for (int i = 0; i < 4; ++i) { v[i] = *(const f32x4*)(srow + 4 * i); mx = fmaxf(mx, fmaxf(fmaxf(fabsf(v[i].x), fabsf(v[i].y)), fmaxf(fabsf(v[i].z), fabsf(v[i].w)))); }
#pragma unroll
        for (int o = 1; o < 64; o <<= 1) mx = fmaxf(mx, shx(mx, o, lane));
        const float qmax = tb ? 224.f : 127.f; const float inv = mx > 0.f ? qmax / mx : 0.f;
        u32x4 w;
        if (tb == 0) {
#pragma unroll
            for (int i = 0; i < 4; ++i) { const int q0 = (int)rintf(v[i].x * inv), q1 = (int)rintf(v[i].y * inv), q2 = (int)rintf(v[i].z * inv), q3 = (int)rintf(v[i].w * inv);
                w[i] = (unsigned)(q0 & 255) | ((unsigned)(q1 & 255) << 8) | ((unsigned)(q2 & 255) << 16) | ((unsigned)(q3 & 255) << 24); }
        } else {
#pragma unroll
            for (int i = 0; i < 4; ++i) { int p = __builtin_amdgcn_cvt_pk_fp8_f32(v[i].x * inv, v[i].y * inv, 0, false); p = __builtin_amdgcn_cvt_pk_fp8_f32(v[i].z * inv, v[i].w * inv, p, true); w[i] = (unsigned)p; }
        }
        uchar* dst = a.ws + (tb ? WS_TV : WS_TU) + (size_t)l * (16 * MiB) + (size_t)(lane >> 3) * (2 * MiB) + (size_t)eid * 128 + (lane & 7) * 16;
        *(u32x4*)dst = w;
        if (lane == 0) scl[(tb * 2 + l) * 16384 + eid] = mx / qmax;
    }
}

__device__ __forceinline__ void phase_k(const Frame& F, const Args& a) {
    const int lane = F.lane;
    const float* SC = (const float*)(a.ws + WS_SC); uchar* Hrow = a.ws + WS_H; float* hs = (float*)(a.ws + WS_HS);
    unsigned short* IDX = (unsigned short*)(a.ws + WS_IDX); float* GATE = (float*)(a.ws + WS_GATE);
    LAS unsigned* keys1 = (LAS unsigned*)(F.lds + RING_OFF + F.wave * 2048);
    LAS unsigned* keys2 = keys1 + 256;
    LAS uchar* tab = F.lds + RING_OFF + OFF_TAB;
    if (F.tid < 64) { int cnt = 0, code = 0xFF;
#pragma unroll
        for (int i = 0; i < 16; ++i) { const int n = 16 / (i + 1); if (F.tid >= cnt && F.tid < cnt + n) code = (i << 4) | (F.tid - cnt); cnt += n; }
        tab[F.tid] = (uchar)code; }
    __syncthreads();
    for (int t = F.gw; t < T; t += F.NGW) {
        unsigned a16[16], c2[16];
        { const int g = lane >> 2, i4 = lane & 3; const f32x4* sp = (const f32x4*)(SC + (size_t)t * 2048 + g * 128) + i4;
#pragma unroll
          for (int k = 0; k < 4; ++k) { const f32x4 v = sp[4 * k]; const int n0 = 16 * k + 4 * i4;
              a16[4 * k + 0] = (mono(v.x) & ~127u) | (unsigned)(127 - (n0 + 0)); a16[4 * k + 1] = (mono(v.y) & ~127u) | (unsigned)(127 - (n0 + 1));
              a16[4 * k + 2] = (mono(v.z) & ~127u) | (unsigned)(127 - (n0 + 2)); a16[4 * k + 3] = (mono(v.w) & ~127u) | (unsigned)(127 - (n0 + 3)); }
#pragma unroll
          for (int k = 4; k < 8; ++k) { const f32x4 v = sp[4 * k]; const int n0 = 16 * k + 4 * i4;
              c2[4 * (k - 4) + 0] = (mono(v.x) & ~127u) | (unsigned)(127 - (n0 + 0)); c2[4 * (k - 4) + 1] = (mono(v.y) & ~127u) | (unsigned)(127 - (n0 + 1));
              c2[4 * (k - 4) + 2] = (mono(v.z) & ~127u) | (unsigned)(127 - (n0 + 2)); c2[4 * (k - 4) + 3] = (mono(v.w) & ~127u) | (unsigned)(127 - (n0 + 3)); } }
        bitonic_sort_desc<16>(a16); bitonic_sort_desc<16>(c2);
#pragma unroll
        for (int i = 0; i < 16; ++i) a16[i] = umax(a16[i], c2[15 - i]);
        bitonic_merge_desc<16>(a16);
        merge_partner16(a16, 1, lane); merge_partner16(a16, 2, lane);
        if ((lane & 3) == 0) {
#pragma unroll
            for (int i = 0; i < 4; ++i) *(LAS u32x4*)(keys1 + (lane >> 2) * 16 + 4 * i) = (u32x4){a16[4 * i], a16[4 * i + 1], a16[4 * i + 2], a16[4 * i + 3]}; }
        LDS_WAIT();
        { const int hd = lane >> 3, sl = lane & 7; unsigned x[16];
#pragma unroll
          for (int jj = 0; jj < 8; ++jj) { const unsigned code = tab[sl * 8 + jj]; const unsigned i = (code >> 4) & 15u, j = code & 15u;
              const unsigned k0 = keys1[(2 * hd) * 16 + i], k1 = keys1[(2 * hd + 1) * 16 + j];
              const float s = demono(k0 & ~127u) + demono(k1 & ~127u);
              x[jj] = code == 0xFFu ? 0u : ((mono(s) & ~255u) | (255u - code)); }
          { unsigned y[8];
#pragma unroll
            for (int i = 0; i < 8; ++i) y[i] = x[i];
            bitonic_sort_desc<8>(y);
#pragma unroll
            for (int i = 0; i < 8; ++i) x[i] = y[i];
#pragma unroll
            for (int i = 0; i < 8; ++i) x[8 + i] = shxu(y[7 - i], 1, lane); }
          bitonic_merge_desc<16>(x);
          merge_partner16(x, 2, lane); merge_partner16(x, 4, lane);
          if (sl == 0) {
#pragma unroll
              for (int i = 0; i < 4; ++i) *(LAS u32x4*)(keys2 + hd * 16 + 4 * i) = (u32x4){x[4 * i], x[4 * i + 1], x[4 * i + 2], x[4 * i + 3]}; } }
        LDS_WAIT();
        { const int r = lane & 15;
#pragma unroll
          for (int hsel = 0; hsel < 2; ++hsel) { const int hd = (lane >> 4) + 4 * hsel;
              const unsigned ck = keys2[hd * 16 + r]; const unsigned flat = 255u - (ck & 255u); const unsigned i = flat >> 4, j = flat & 15u;
              const unsigned k0 = keys1[(2 * hd) * 16 + i], k1 = keys1[(2 * hd + 1) * 16 + j];
              const unsigned eid = (127u - (k0 & 127u)) * 128u + (127u - (k1 & 127u));
              const float s = demono(k0 & ~127u) + demono(k1 & ~127u);
              float mx = s; mx = fmaxf(mx, shx(mx, 1, lane)); mx = fmaxf(mx, shx(mx, 2, lane)); mx = fmaxf(mx, shx(mx, 4, lane)); mx = fmaxf(mx, shx(mx, 8, lane));
              const float e = __expf(s - mx); float sum = e; sum += shx(sum, 1, lane); sum += shx(sum, 2, lane); sum += shx(sum, 4, lane); sum += shx(sum, 8, lane);
              IDX[(size_t)t * 128 + 64 * hsel + lane] = (unsigned short)eid; GATE[(size_t)t * 128 + 64 * hsel + lane] = e / sum; } }
        { uchar* hr = Hrow + (size_t)t * 2048; const u32x4 h0 = *(const u32x4*)(hr + 16 * lane), h1 = *(const u32x4*)(hr + 1024 + 16 * lane);
          float mx = 0.f;
#pragma unroll
          for (int i = 0; i < 4; ++i) mx = fmaxf(mx, fmaxf(fmaxf(fabsf(bf_lo(h0[i])), fabsf(bf_hi(h0[i]))), fmaxf(fabsf(bf_lo(h1[i])), fabsf(bf_hi(h1[i])))));
#pragma unroll
          for (int o = 1; o < 64; o <<= 1) mx = fmaxf(mx, shx(mx, o, lane));
          const float inv = mx > 0.f ? 127.f / mx : 0.f;
          u32x2 q0, q1;
#pragma unroll
          for (int i = 0; i < 2; ++i) {
              q0[i] = (unsigned)((int)rintf(bf_lo(h0[2 * i]) * inv) & 255) | ((unsigned)((int)rintf(bf_hi(h0[2 * i]) * inv) & 255) << 8) | ((unsigned)((int)rintf(bf_lo(h0[2 * i + 1]) * inv) & 255) << 16) | ((unsigned)((int)rintf(bf_hi(h0[2 * i + 1]) * inv) & 255) << 24);
              q1[i] = (unsigned)((int)rintf(bf_lo(h1[2 * i]) * inv) & 255) | ((unsigned)((int)rintf(bf_hi(h1[2 * i]) * inv) & 255) << 8) | ((unsigned)((int)rintf(bf_lo(h1[2 * i + 1]) * inv) & 255) << 16) | ((unsigned)((int)rintf(bf_hi(h1[2 * i + 1]) * inv) & 255) << 24); }
          *(u32x2*)(hr + 8 * lane) = q0; *(u32x2*)(hr + 512 + 8 * lane) = q1;
          if (lane == 0) hs[t] = mx * (1.f / 127.f); }
    }
}

__device__ __forceinline__ void phase_u(const Frame& F, const Args& a, int layer) {
    const int lane = F.lane, G = lane >> 3, seg = lane & 7;
    const int x = (int)(blockIdx.x & 7), wrank = (int)(blockIdx.x >> 3) * NWAVES + F.wave, nw = (int)(gridDim.x >> 3) * NWAVES;
    const uchar* tu = a.ws + WS_TU + (size_t)layer * (16 * MiB) + (size_t)x * (2 * MiB) + seg * 16;
    const uchar* Hrow = a.ws + WS_H + 128 * x + 16 * seg; const uchar* IDX = a.ws + WS_IDX + 32 * G;
    int* ZP = (int*)(a.ws + WS_ZP) + (size_t)x * T * 128 + 16 * G + 2 * seg;
    for (int t0 = 2 * wrank; t0 < T; t0 += 2 * nw) {
        u32x4 iw[2][2], hq[2], r[2][16];
#pragma unroll
        for (int u = 0; u < 2; ++u) { const u32x4* ip = (const u32x4*)(IDX + (size_t)(t0 + u) * 256); iw[u][0] = ip[0]; iw[u][1] = ip[1]; hq[u] = *(const u32x4*)(Hrow + (size_t)(t0 + u) * 2048); }
#pragma unroll
        for (int u = 0; u < 2; ++u)
#pragma unroll
            for (int j = 0; j < 16; ++j) { const unsigned w = iw[u][j >> 3][(j >> 1) & 3]; const unsigned eid = (j & 1) ? (w >> 16) : (w & 0xffffu); r[u][j] = *(const u32x4*)(tu + (size_t)eid * 128); }
#pragma unroll
        for (int u = 0; u < 2; ++u) {
            int p[16];
#pragma unroll
            for (int j = 0; j < 16; ++j) { int d = __builtin_amdgcn_sdot4((int)r[u][j].x, (int)hq[u].x, 0, false); d = __builtin_amdgcn_sdot4((int)r[u][j].y, (int)hq[u].y, d, false);
                d = __builtin_amdgcn_sdot4((int)r[u][j].z, (int)hq[u].z, d, false); d = __builtin_amdgcn_sdot4((int)r[u][j].w, (int)hq[u].w, d, false); p[j] = d; }
            int q8[8], q4[4], q2[2];
#pragma unroll
            for (int i = 0; i < 8; ++i) { const bool up = (lane & 4) != 0; const int keep = up ? p[i + 8] : p[i], send = up ? p[i] : p[i + 8]; q8[i] = keep + (int)shxu((unsigned)send, 4, lane); }
#pragma unroll
            for (int i = 0; i < 4; ++i) { const bool up = (lane & 2) != 0; const int keep = up ? q8[i + 4] : q8[i], send = up ? q8[i] : q8[i + 4]; q4[i] = keep + (int)shxu((unsigned)send, 2, lane); }
#pragma unroll
            for (int i = 0; i < 2; ++i) { const bool up = (lane & 1) != 0; const int keep = up ? q4[i + 2] : q4[i], send = up ? q4[i] : q4[i + 2]; q2[i] = keep + (int)shxu((unsigned)send, 1, lane); }
            *(u32x2*)(ZP + (size_t)(t0 + u) * 128) = (u32x2){(unsigned)q2[0], (unsigned)q2[1]};
        }
    }
}

__device__ __forceinline__ void phase_z(const Frame& F, const Args& a, int layer) {
    const int lane = F.lane;
    const int* ZP = (const int*)(a.ws + WS_ZP); const unsigned short* IDX = (const unsigned short*)(a.ws + WS_IDX); const float* GATE = (const float*)(a.ws + WS_GATE);
    const float* su = (const float*)(a.ws + WS_SCL) + layer * 16384; const float* sv = su + 2 * 16384; const float* hs = (const float*)(a.ws + WS_HS);
    float* AK = (float*)(a.ws + WS_AK);
    for (int t = F.gw; t < T; t += F.NGW) {
        const float hsc = hs[t];
#pragma unroll
        for (int hsel = 0; hsel < 2; ++hsel) { const int slot = 64 * hsel + lane; int zi = 0;
#pragma unroll
            for (int xs = 0; xs < 8; ++xs) zi += ZP[((size_t)xs * T + t) * 128 + slot];
            const int eid = IDX[(size_t)t * 128 + slot];
            const float z = (float)zi * (hsc * su[eid]);
            AK[(size_t)t * 128 + slot] = gelu_exact(z) * GATE[(size_t)t * 128 + slot] * sv[eid]; }
    }
}

__device__ __forceinline__ void phase_v(const Frame& F, const Args& a, int layer, const float* gate_f) {
    const int lane = F.lane, G = lane >> 3, seg = lane & 7;
    const int x = (int)(blockIdx.x & 7), wrank = (int)(blockIdx.x >> 3) * NWAVES + F.wave, nw = (int)(gridDim.x >> 3) * NWAVES;
    const uchar* tv = a.ws + WS_TV + (size_t)layer * (16 * MiB) + (size_t)x * (2 * MiB) + seg * 16;
    const uchar* IDX = a.ws + WS_IDX + 32 * G; const float* AK = (const float*)(a.ws + WS_AK) + 16 * G;
    const int col = 128 * x + 16 * seg + 2 * G;
    for (int t = wrank; t < T; t += nw) {
        const u32x4* ip = (const u32x4*)(IDX + (size_t)t * 256); const u32x4 iw0 = ip[0], iw1 = ip[1];
        const f32x4* ap = (const f32x4*)(AK + (size_t)t * 128); const f32x4 a0 = ap[0], a1 = ap[1], a2 = ap[2], a3 = ap[3];
        const float ak[16] = {a0.x, a0.y, a0.z, a0.w, a1.x, a1.y, a1.z, a1.w, a2.x, a2.y, a2.z, a2.w, a3.x, a3.y, a3.z, a3.w};
        u32x4 r[16];
#pragma unroll
        for (int j = 0; j < 16; ++j) { const unsigned w = (j < 8 ? iw0 : iw1)[(j >> 1) & 3]; const unsigned eid = (j & 1) ? (w >> 16) : (w & 0xffffu); r[j] = *(const u32x4*)(tv + (size_t)eid * 128); }
        f32x2 acc[8];
#pragma unroll
        for (int i = 0; i < 8; ++i) acc[i] = (f32x2){0.f, 0.f};
#pragma unroll
        for (int j = 0; j < 16; ++j) { const f32x2 s = {ak[j], ak[j]};
#pragma unroll
            for (int d = 0; d < 4; ++d) { const unsigned w = r[j][d];
                acc[2 * d] = __builtin_elementwise_fma(__builtin_amdgcn_cvt_pk_f32_fp8((int)w, false), s, acc[2 * d]);
                acc[2 * d + 1] = __builtin_elementwise_fma(__builtin_amdgcn_cvt_pk_f32_fp8((int)w, true), s, acc[2 * d + 1]); } }
        f32x2 b4[4], b2[2], b1;
#pragma unroll
        for (int i = 0; i < 4; ++i) { const bool up = (lane & 32) != 0; const f32x2 keep = up ? acc[i + 4] : acc[i], send = up ? acc[i] : acc[i + 4]; b4[i].x = keep.x + shx(send.x, 32, lane); b4[i].y = keep.y + shx(send.y, 32, lane); }
#pragma unroll
        for (int i = 0; i < 2; ++i) { const bool up = (lane & 16) != 0; const f32x2 keep = up ? b4[i + 2] : b4[i], send = up ? b4[i] : b4[i + 2]; b2[i].x = keep.x + shx(send.x, 16, lane); b2[i].y = keep.y + shx(send.y, 16, lane); }
        { const bool up = (lane & 8) != 0; const f32x2 keep = up ? b2[1] : b2[0], send = up ? b2[0] : b2[1]; b1.x = keep.x + shx(send.x, 8, lane); b1.y = keep.y + shx(send.y, 8, lane); }
        float* xp = a.out + (size_t)t * 1024 + col; const f32x2 gf = *(const f32x2*)(gate_f + (size_t)(t >> 12) * 6144 + col);
        const f32x2 xo = *(const f32x2*)xp; *(f32x2*)xp = xo + gf * b1;
    }
}
}

__global__ void __launch_bounds__(NTHR, 2) fwd_kernel(Args args) {
    extern __shared__ __attribute__((aligned(16))) uchar lds_raw[];
    Frame F;
    F.lds = (LAS uchar*)lds_raw;
    F.wave = __builtin_amdgcn_readfirstlane((int)threadIdx.x >> 6); F.tid = threadIdx.x; F.lane = F.tid & 63;
    F.G = gridDim.x; { const int bx = blockIdx.x; F.vcu = (F.G % 8 == 0) ? (bx % 8) * (F.G / 8) + bx / 8 : bx; }
    F.gw = F.vcu * NWAVES + F.wave; F.NGW = F.G * NWAVES;
#define F_REFRESH() do { int l_; asm volatile("v_mbcnt_lo_u32_b32 %0, -1, 0\n\tv_mbcnt_hi_u32_b32 %0, -1, %0" : "=v"(l_)); F.lane = l_; F.tid = F.wave * 64 + l_; } while (0)
    volatile LAS unsigned* MISC = (volatile LAS unsigned*)(F.lds + MISC_OFF);
    for (int u = F.tid; u < (LDS_BYTES - LDSCTL_OFF) / 4; u += NTHR) ((LAS unsigned*)(F.lds + LDSCTL_OFF))[u] = 0u;
    __syncthreads();
    XcdBarrier bar = xcd_barrier_post((unsigned*)(args.ws + WS_CTL) + CW_BAR, MISC + 8);
    const float* mod0 = (const float*)(args.ws + WS_MOD);
    const float* mod1 = mod0 + 8 * 6144;

    p0_mod(F, args);
    p0_wcomb(F, args);
    p0_weights(F, args);
    p0_rope(F, args);
    peer2::convert_tables_q(F, args);
    xcd_barrier(bar, F.tid); F_REFRESH();
    norm_rows_adaln(F, args.x, args.norm_mix_g, mod0, 0, 1024, (bf16*)(args.ws + WS_H));
    xcd_barrier(bar, F.tid); F_REFRESH();
    bf16* const Hb = (bf16*)(args.ws + WS_H); bf16* const PROJ = (bf16*)(args.ws + WS_PROJ); bf16* const Qb = (bf16*)(args.ws + WS_Q); bf16* const KVb = (bf16*)(args.ws + WS_KV);
    {   pg8::Gemm g{Hb, (const bf16*)(args.ws + WS_WIN), T, AB_INP, 1024, 1024}; pg8::StaticOrder S; S.init(T, AB_INP, F.G, (int)blockIdx.x);
        pg8::EpiGen<0> E{PROJ, AB_INP, nullptr, nullptr, nullptr};
        pg8::gemm_phase<pg8::EpiGen<0>, pg8::StaticOrder>(F.lds + RING_OFF, g, S, E, F.tid, F.wave); }
    F_REFRESH();
    xcd_barrier(bar, F.tid); F_REFRESH();
#if CHECKS
    gemm_check(F, args, Hb, 1024, (const bf16*)(args.ws + WS_WIN), 1024, AB_INP, PROJ, AB_INP, 0, nullptr, nullptr, nullptr, 0);
    xcd_barrier(bar, F.tid); F_REFRESH();
#endif
    p3_post(F, args);
    xcd_barrier(bar, F.tid); F_REFRESH();
    {   pg8::Gemm g{PROJ + C_QLAT, (const bf16*)(args.ws + WS_WUQ), T, 768, 256, AB_INP}; pg8::StaticOrder S; S.init(T, 768, F.G, (int)blockIdx.x);
        pg8::EpiGen<0> E{Qb, 768, (const float*)(args.ws + WS_RSTDQ), nullptr, nullptr};
        pg8::gemm_phase<pg8::EpiGen<0>, pg8::StaticOrder>(F.lds + RING_OFF, g, S, E, F.tid, F.wave); }
    F_REFRESH();
    {   pg8::Gemm g{PROJ + C_KVLAT, (const bf16*)(args.ws + WS_WUKV), T, 1024, 128, AB_INP}; pg8::StaticOrder S; S.init(T, 1024, F.G, (int)blockIdx.x);
        pg8::EpiGen<0> E{KVb, 1024, (const float*)(args.ws + WS_RSTDKV), nullptr, nullptr};
        pg8::gemm_phase<pg8::EpiGen<0>, pg8::StaticOrder>(F.lds + RING_OFF, g, S, E, F.tid, F.wave); }
    F_REFRESH();
    xcd_barrier(bar, F.tid); F_REFRESH();
#if CHECKS
    gemm_check(F, args, PROJ + C_QLAT, AB_INP, (const bf16*)(args.ws + WS_WUQ), 256, 768, Qb, 768, 0, (const float*)(args.ws + WS_RSTDQ), nullptr, nullptr, 1);
    gemm_check(F, args, PROJ + C_KVLAT, AB_INP, (const bf16*)(args.ws + WS_WUKV), 128, 1024, KVb, 1024, 0, (const float*)(args.ws + WS_RSTDKV), nullptr, nullptr, 2);
    xcd_barrier(bar, F.tid); F_REFRESH();
#endif
    att::Tensors AX;
    AX.Q = Qb; AX.KV = KVb; AX.PROJ = PROJ; AX.QKV = (const bf16*)(args.ws + WS_QKV); AX.O = (bf16*)(args.ws + WS_MRG);
    AX.ropeA = (const float*)(args.ws + WS_ROPEA); AX.ropeB = (const float*)(args.ws + WS_ROPEB); AX.rel_bias = args.rel_bias; AX.hng = args.diff_head_norm_g;
    {   const int li = F.lane & 31; const float m01 = args.diff_lambda[li] * args.diff_lambda[32 + li], m23 = args.diff_lambda[64 + li] * args.diff_lambda[96 + li];
        const float d01 = wave_sum(F.lane < 32 ? m01 : 0.f, F.lane), d23 = wave_sum(F.lane < 32 ? m23 : 0.f, F.lane);
        AX.lam = expf(d01) - expf(d23) + 0.2f; }
    for (int wsel = F.vcu; wsel < 256; wsel += F.G) {
        const int bh = wsel >> 2, g = wsel & 3, b = bh >> 3, head = bh & 7;
        for (int i = 0; i < 4 * REP_ATT; ++i) { const int ii = i & 3; const int qt = (ii == 0) ? 15 - 2 * g : (ii == 1) ? 14 - 2 * g : (ii == 2) ? 2 * g + 1 : 2 * g; att::attn_unit<0>(F, F.lds + RING_OFF, AX, b, head, qt); }
        for (int i = 0; i < 4 * REP_ATT; ++i) { const int ii = i & 3; const int qt = (ii == 0) ? 15 - 2 * g : (ii == 1) ? 14 - 2 * g : (ii == 2) ? 2 * g + 1 : 2 * g; att::attn_unit<1>(F, F.lds + RING_OFF, AX, b, head, qt); }
    }
    xcd_barrier(bar, F.tid); F_REFRESH();
#if CHECKS
    att::attn_check<0>(F, args, AX, 3);
    att::attn_check<1>(F, args, AX, 4);
    xcd_barrier(bar, F.tid); F_REFRESH();
#endif
    bf16* const MRG = (bf16*)(args.ws + WS_MRG);
    {   pg8::Gemm g{MRG, (const bf16*)(args.ws + WS_WOAB), T, 1024, 1024, 1024}; pg8::StaticOrder S; S.init(T, 1024, F.G, (int)blockIdx.x);
        pg8::EpiGen<1> E{args.out, 1024, nullptr, args.x, mod0 + 2048};
        pg8::gemm_phase<pg8::EpiGen<1>, pg8::StaticOrder>(F.lds + RING_OFF, g, S, E, F.tid, F.wave); }
    F_REFRESH();
    xcd_barrier(bar, F.tid); F_REFRESH();
#if CHECKS
    gemm_check(F, args, MRG, 1024, (const bf16*)(args.ws + WS_WOAB), 1024, 1024, args.out, 1024, 1, nullptr, args.x, mod0 + 2048, 5);
    xcd_barrier(bar, F.tid); F_REFRESH();
#endif
    norm_rows_adaln(F, args.out, args.norm_ffn_g, mod0, 3072, 4096, Hb);
    xcd_barrier(bar, F.tid); F_REFRESH();
    float* const SCb = (float*)(args.ws + WS_SC);
    {   pg8::Gemm g{Hb, (const bf16*)(args.ws + WS_WCOMB), T, 2048, 1024, 1024}; pg8::StaticOrder S; S.init(T, 2048, F.G, (int)blockIdx.x);
        pg8::EpiGen<2> E{SCb, 2048, nullptr, nullptr, nullptr};
        pg8::gemm_phase<pg8::EpiGen<2>, pg8::StaticOrder>(F.lds + RING_OFF, g, S, E, F.tid, F.wave); }
    F_REFRESH();
    xcd_barrier(bar, F.tid); F_REFRESH();
#if CHECKS
    gemm_check(F, args, Hb, 1024, (const bf16*)(args.ws + WS_WCOMB), 1024, 2048, SCb, 2048, 2, nullptr, nullptr, nullptr, 6);
    xcd_barrier(bar, F.tid); F_REFRESH();
#endif
    peer2::phase_k(F, args);
    xcd_barrier(bar, F.tid); F_REFRESH();
    peer2::phase_u(F, args, 0);
    xcd_barrier(bar, F.tid); F_REFRESH();
    peer2::phase_z(F, args, 0);
    xcd_barrier(bar, F.tid); F_REFRESH();
    peer2::phase_v(F, args, 0, mod0 + 5120);
    xcd_barrier(bar, F.tid); F_REFRESH();
    norm_rows_adaln(F, args.out, args.norm_mix_g + 1024, mod1, 0, 1024, Hb);
    xcd_barrier(bar, F.tid); F_REFRESH();
    bf16* const QKVb = (bf16*)(args.ws + WS_QKV);
    {   pg8::Gemm g{Hb, (const bf16*)(args.ws + WS_WINC), T, 3072, 1024, 1024}; pg8::StaticOrder S; S.init(T, 3072, F.G, (int)blockIdx.x);
        pg8::EpiGen<0> E{QKVb, 3072, nullptr, nullptr, nullptr};
        pg8::gemm_phase<pg8::EpiGen<0>, pg8::StaticOrder>(F.lds + RING_OFF, g, S, E, F.tid, F.wave); }
    F_REFRESH();
    xcd_barrier(bar, F.tid); F_REFRESH();
    for (int wsel = F.vcu; wsel < 256; wsel += F.G) {
        const int bh = wsel >> 1, g = wsel & 1, b = bh >> 4, head = bh & 15;
        for (int i = 0; i < 8 * REP_ATT; ++i) att::attn_unit<2>(F, F.lds + RING_OFF, AX, b, head, 15 - (2 * (i & 7) + g));
    }
    xcd_barrier(bar, F.tid); F_REFRESH();
#if CHECKS
    att::attn_check<2>(F, args, AX, 8);
    xcd_barrier(bar, F.tid); F_REFRESH();
#endif
    {   pg8::Gemm g{MRG, (const bf16*)(args.ws + WS_WOC), T, 1024, 1024, 1024}; pg8::StaticOrder S; S.init(T, 1024, F.G, (int)blockIdx.x);
        pg8::EpiGen<1> E{args.out, 1024, nullptr, args.out, mod1 + 2048};
        pg8::gemm_phase<pg8::EpiGen<1>, pg8::StaticOrder>(F.lds + RING_OFF, g, S, E, F.tid, F.wave); }
    F_REFRESH();
    xcd_barrier(bar, F.tid); F_REFRESH();
    norm_rows_adaln(F, args.out, args.norm_ffn_g + 1024, mod1, 3072, 4096, Hb);
    xcd_barrier(bar, F.tid); F_REFRESH();
    {   pg8::Gemm g{Hb, (const bf16*)(args.ws + WS_WCOMB) + (size_t)2048 * 1024, T, 2048, 1024, 1024}; pg8::StaticOrder S; S.init(T, 2048, F.G, (int)blockIdx.x);
        pg8::EpiGen<2> E{SCb, 2048, nullptr, nullptr, nullptr};
        pg8::gemm_phase<pg8::EpiGen<2>, pg8::StaticOrder>(F.lds + RING_OFF, g, S, E, F.tid, F.wave); }
    F_REFRESH();
    xcd_barrier(bar, F.tid); F_REFRESH();
    peer2::phase_k(F, args);
    xcd_barrier(bar, F.tid); F_REFRESH();
    peer2::phase_u(F, args, 1);
    xcd_barrier(bar, F.tid); F_REFRESH();
    peer2::phase_z(F, args, 1);
    xcd_barrier(bar, F.tid); F_REFRESH();
    peer2::phase_v(F, args, 1, mod1 + 5120);
    xcd_barrier(bar, F.tid); F_REFRESH();
    norm_rows_final(F, args.out, args.final_norm_g, args.out);
#if CHECKS
    {
        const unsigned* ctl = (const unsigned*)(args.ws + WS_CTL);
        unsigned code = 0; for (int k = 0; k < 9; ++k) if (__hip_atomic_load(ctl + CW_CHK + k, __ATOMIC_RELAXED, __HIP_MEMORY_SCOPE_AGENT)) code |= 1u << k;
        if (__hip_atomic_load(ctl + CW_BAR + XB_TMO, __ATOMIC_RELAXED, __HIP_MEMORY_SCOPE_AGENT)) code |= 1u << 9;
        if (code) { xcd_barrier(bar, F.tid); const float scl = 1.f + (float)code;
            for (size_t i = (size_t)F.vcu * NTHR + F.tid; i < (size_t)T * D; i += (size_t)F.G * NTHR) args.out[i] *= scl; }
    }
#endif
}

extern "C" void kernel_launch(void* const* d_in, const int* in_sizes, int n_in, void* d_out, int out_size, void* d_ws, size_t ws_size, hipStream_t stream) {
    static int grid = 0;
    if (grid == 0) {
        if (n_in != 23 || out_size != T * D || ws_size < WS_END) { fprintf(stderr, "kernel_launch: unexpected shapes (n_in %d out %d ws %zu)\n", n_in, out_size, ws_size); grid = -1; return; }
        int dev = 0, cus = 0, per_cu = 0;
        if (hipGetDevice(&dev) != hipSuccess || hipDeviceGetAttribute(&cus, hipDeviceAttributeMultiprocessorCount, dev) != hipSuccess) { grid = -1; return; }
        if (hipFuncSetAttribute((const void*)fwd_kernel, hipFuncAttributeMaxDynamicSharedMemorySize, LDS_BYTES) != hipSuccess) { fprintf(stderr, "kernel_launch: hipFuncSetAttribute failed\n"); grid = -1; return; }
        if (hipOccupancyMaxActiveBlocksPerMultiprocessor(&per_cu, (const void*)fwd_kernel, NTHR, LDS_BYTES) != hipSuccess || per_cu < 1)
            fprintf(stderr, "kernel_launch: occupancy query reports %d per CU\n", per_cu);
        (void)hipGetLastError();
        grid = cus;
    }
    if (grid < 0) return;
    if (hipMemsetAsync((char*)d_ws + WS_CTL, 0, CTL_ZERO_BYTES, stream) != hipSuccess) return;
    Args a{};
    a.x = (const float*)d_in[0]; a.c = (const float*)d_in[1]; a.pos = (const int*)d_in[2]; a.ada_w = (const float*)d_in[3]; a.ada_b = (const float*)d_in[4];
    a.norm_mix_g = (const float*)d_in[5]; a.norm_ffn_g = (const float*)d_in[6]; a.w_in_ab = (const float*)d_in[7]; a.mla_q_norm_g = (const float*)d_in[8];
    a.mla_w_uq = (const float*)d_in[9]; a.mla_kv_norm_g = (const float*)d_in[10]; a.mla_w_ukv = (const float*)d_in[11]; a.diff_lambda = (const float*)d_in[12];
    a.diff_head_norm_g = (const float*)d_in[13]; a.w_out_ab = (const float*)d_in[14]; a.w_in_c = (const float*)d_in[15]; a.rel_bias = (const float*)d_in[16];
    a.w_out_c = (const float*)d_in[17]; a.peer_w_q = (const float*)d_in[18]; a.peer_sub_keys = (const float*)d_in[19]; a.peer_u = (const float*)d_in[20];
    a.peer_v = (const float*)d_in[21]; a.final_norm_g = (const float*)d_in[22];
    a.out = (float*)d_out; a.ws = (uchar*)d_ws;
    for (int i = 0; i < 16; ++i) a.inv_freq_a[i] = (float)pow(500000.0, -(double)(2 * i) / 32.0);
    for (int i = 0; i < 4; ++i) a.inv_freq_b[i] = (float)pow(500000.0, -(double)(2 * i) / 8.0);
    hipLaunchKernelGGL(fwd_kernel, dim3(grid), dim3(NTHR), LDS_BYTES, stream, a);
}
```
